# Optimizing an MI355X kernel written in HIP

```python
import math
import jax, jax.numpy as jnp
from jax import lax
import numpy as np

D_MODEL = 1024
BATCH = 2
SEQ = 8192
DEPTH = 1

CHUNK = 64
Q_BLOCK = 128
ROPE_THETA = 10000.0
NORM_EPS = 1e-6
SUBLN_EPS = 1e-5

DA_WIDTH = D_MODEL
DA_QK_DIM = 64
DA_V_DIM = 2 * DA_QK_DIM
DA_HEADS = DA_WIDTH // DA_V_DIM

FOX_WIDTH = D_MODEL
FOX_HEAD_DIM = 128
FOX_HEADS = FOX_WIDTH // FOX_HEAD_DIM

IN_SIZES = [DA_WIDTH, DA_WIDTH, DA_WIDTH, DA_WIDTH,
            FOX_WIDTH, FOX_WIDTH, FOX_WIDTH, FOX_WIDTH,
            FOX_HEADS,
            D_MODEL, D_MODEL]
N_IN = sum(IN_SIZES)
IN_SPLITS = [int(v) for v in np.cumsum(IN_SIZES)[:-1]]

kernel_name = "hybrid_diff_fox_gated_block"


def rms_norm(x, g, eps=NORM_EPS):
    xf = x.astype(jnp.float32)
    y = xf * lax.rsqrt(jnp.mean(xf * xf, axis=-1, keepdims=True) + eps)
    return (y * g.astype(jnp.float32)).astype(x.dtype)


def to_heads(t, n):
    b, s, _ = t.shape
    return t.reshape(b, s, n, -1).transpose(0, 2, 1, 3)


def merge_heads(t):
    b, h, s, d = t.shape
    return t.transpose(0, 2, 1, 3).reshape(b, s, h * d)


def rope(t, positions):
    half = t.shape[-1] // 2
    inv_freq = ROPE_THETA ** (-jnp.arange(half, dtype=jnp.float32) / half)
    ang = positions.astype(jnp.float32)[:, None, :, None] * inv_freq
    cos, sin = jnp.cos(ang), jnp.sin(ang)
    tf = t.astype(jnp.float32)
    t1, t2 = tf[..., :half], tf[..., half:]
    return jnp.concatenate([t1 * cos - t2 * sin, t1 * sin + t2 * cos], axis=-1).astype(t.dtype)


def diff_attention(q1, q2, k1, k2, v, lam):
    s_len = q1.shape[2]
    scale = DA_QK_DIM ** -0.5
    outs = []
    for qb in range(s_len // Q_BLOCK):
        q0, kend = qb * Q_BLOCK, (qb + 1) * Q_BLOCK
        mask = (jnp.arange(kend) // CHUNK)[None, :] <= (jnp.arange(q0, kend) // CHUNK)[:, None]
        s1 = jnp.einsum('bhqd,bhkd->bhqk', q1[:, :, q0:kend], k1[:, :, :kend]).astype(jnp.float32) * scale
        s2 = jnp.einsum('bhqd,bhkd->bhqk', q2[:, :, q0:kend], k2[:, :, :kend]).astype(jnp.float32) * scale
        p1 = jax.nn.softmax(jnp.where(mask, s1, -jnp.inf), axis=-1)
        p2 = jax.nn.softmax(jnp.where(mask, s2, -jnp.inf), axis=-1)
        a = (p1 - lam * p2).astype(v.dtype)
        outs.append(jnp.einsum('bhqk,bhkd->bhqd', a, v[:, :, :kend]))
    return jnp.concatenate(outs, axis=2)


def forgetting_attention(q, k, v, cum_logf):
    s_len = q.shape[2]
    scale = FOX_HEAD_DIM ** -0.5
    outs = []
    for qb in range(s_len // Q_BLOCK):
        q0, kend = qb * Q_BLOCK, (qb + 1) * Q_BLOCK
        mask = jnp.arange(kend)[None, :] <= jnp.arange(q0, kend)[:, None]
        s = (jnp.einsum('bhqd,bhkd->bhqk', q[:, :, q0:kend], k[:, :, :kend]).astype(jnp.float32) * scale
             + cum_logf[:, :, q0:kend, None] - cum_logf[:, :, None, :kend])
        p = jax.nn.softmax(jnp.where(mask, s, -jnp.inf), axis=-1).astype(v.dtype)
        outs.append(jnp.einsum('bhqk,bhkd->bhqd', p, v[:, :, :kend]))
    return jnp.concatenate(outs, axis=2)


def setup_inputs(seed: int = 0) -> dict:
    key = jax.random.key(seed)
    ks = jax.random.split(key, 20)
    f32 = jnp.float32
    d = D_MODEL
    x = jax.random.normal(ks[0], (BATCH, SEQ, d), f32)
    c = jax.random.normal(ks[1], (BATCH, d), f32)
    offset = jax.random.randint(ks[2], (BATCH, 1), 0, 4096, dtype=jnp.int32)
    positions = (offset + jnp.arange(SEQ, dtype=jnp.int32)[None, :]).astype(jnp.int32)
    w_ada = jax.random.normal(ks[3], (DEPTH, d, 3 * d), f32) * (0.5 * d ** -0.5)
    b_ada = jax.random.normal(ks[4], (DEPTH, 3 * d), f32) * 0.02
    g_norm = 1.0 + 0.05 * jax.random.normal(ks[5], (DEPTH, d), f32)
    w_in = jax.random.normal(ks[6], (DEPTH, d, N_IN), f32) * d ** -0.5
    b_forget = 2.0 + 0.5 * jax.random.normal(ks[7], (DEPTH, FOX_HEADS), f32)
    lambda_q1 = 0.1 * jax.random.normal(ks[8], (DEPTH, DA_QK_DIM), f32)
    lambda_k1 = 0.1 * jax.random.normal(ks[9], (DEPTH, DA_QK_DIM), f32)
    lambda_q2 = 0.1 * jax.random.normal(ks[10], (DEPTH, DA_QK_DIM), f32)
    lambda_k2 = 0.1 * jax.random.normal(ks[11], (DEPTH, DA_QK_DIM), f32)
    g_subln = 1.0 + 0.05 * jax.random.normal(ks[12], (DEPTH, DA_V_DIM), f32)
    w_branch_a = jax.random.normal(ks[13], (DEPTH, DA_WIDTH, d), f32) * DA_WIDTH ** -0.5
    w_branch_b = jax.random.normal(ks[14], (DEPTH, FOX_WIDTH, d), f32) * FOX_WIDTH ** -0.5
    w_out = jax.random.normal(ks[15], (DEPTH, d, d), f32) * d ** -0.5
    g_final = 1.0 + 0.05 * jax.random.normal(ks[16], (d,), f32)
    return {"x": x, "c": c, "positions": positions, "w_ada": w_ada, "b_ada": b_ada,
            "g_norm": g_norm, "w_in": w_in, "b_forget": b_forget,
            "lambda_q1": lambda_q1, "lambda_k1": lambda_k1, "lambda_q2": lambda_q2,
            "lambda_k2": lambda_k2, "g_subln": g_subln, "w_branch_a": w_branch_a,
            "w_branch_b": w_branch_b, "w_out": w_out, "g_final": g_final}


def reference(x, c, positions, w_ada, b_ada, g_norm, w_in, b_forget, lambda_q1, lambda_k1,
              lambda_q2, lambda_k2, g_subln, w_branch_a, w_branch_b, w_out, g_final):
    c_act = jax.nn.silu(c)
    for l in range(DEPTH):
        lambda_init = 0.8 - 0.6 * math.exp(-0.3 * l)
        mod = jnp.einsum('bd,de->be', c_act, w_ada[l]) + b_ada[l]
        shift, scale, gate = jnp.split(mod, 3, axis=-1)
        h = rms_norm(x, g_norm[l]) * (1.0 + scale[:, None, :]) + shift[:, None, :]

        proj = jnp.einsum('bsd,de->bse', h, w_in[l])
        (q_a, k_a, v_a, z_a, q_b, k_b, v_b, z_b, f_logit, m_a, m_b) = jnp.split(proj, IN_SPLITS, axis=-1)

        qa = to_heads(q_a, DA_HEADS)
        ka = to_heads(k_a, DA_HEADS)
        q1 = rope(qa[..., :DA_QK_DIM], positions)
        q2 = rope(qa[..., DA_QK_DIM:], positions)
        k1 = rope(ka[..., :DA_QK_DIM], positions)
        k2 = rope(ka[..., DA_QK_DIM:], positions)
        va = to_heads(v_a, DA_HEADS)
        lam = (jnp.exp(jnp.sum(lambda_q1[l].astype(jnp.float32) * lambda_k1[l].astype(jnp.float32)))
               - jnp.exp(jnp.sum(lambda_q2[l].astype(jnp.float32) * lambda_k2[l].astype(jnp.float32)))
               + lambda_init)
        oa = diff_attention(q1, q2, k1, k2, va, lam)
        oa = rms_norm(oa, g_subln[l], SUBLN_EPS) * (1.0 - lambda_init)
        y_a = jnp.einsum('bse,ed->bsd', merge_heads(oa) * jax.nn.silu(z_a), w_branch_a[l])

        log_f = jax.nn.log_sigmoid(f_logit.astype(jnp.float32) + b_forget[l].astype(jnp.float32))
        cum_logf = jnp.cumsum(log_f, axis=1).transpose(0, 2, 1)
        ob = forgetting_attention(to_heads(q_b, FOX_HEADS), to_heads(k_b, FOX_HEADS),
                                  to_heads(v_b, FOX_HEADS), cum_logf)
        y_b = jnp.einsum('bse,ed->bsd', merge_heads(ob) * jax.nn.silu(z_b), w_branch_b[l])

        merged = jax.nn.sigmoid(m_a) * y_a + jax.nn.sigmoid(m_b) * y_b
        out = jnp.einsum('bsd,de->bse', merged, w_out[l])
        x = x + gate[:, None, :] * out
    return rms_norm(x, g_final)
```

```cpp
#include <hip/hip_runtime.h>
#include <hip/hip_bf16.h>
#include <cstdio>
#include <cstdint>
#include <cmath>

constexpr int BATCH = 2, SEQ = 8192, DM = 1024, M = BATCH * SEQ, NH = 8, HD = 128, N_IN = 10248;
constexpr float LOG2E = 1.4426950408889634f;
constexpr float C2A = 0.125f * LOG2E;
constexpr float C2B = 0.08838834764831845f * LOG2E;

namespace pg8 {
#define PG8_LAS __attribute__((address_space(3)))
typedef unsigned short bf16_t;
typedef short bf16x8 __attribute__((ext_vector_type(8)));
typedef float f32x4 __attribute__((ext_vector_type(4)));
typedef unsigned u32x4 __attribute__((ext_vector_type(4)));
constexpr int BM = 256, BK = 64, HALF = 128, HTB = HALF * BK * 2  , STAGE_BYTES = 8 * HTB, NXCD = 8, WGM = 8;

__host__ __device__ __forceinline__ int lds_byte(int r, int c) { const int st = (r >> 4) * 2 + (c >> 5), rr = r & 15, cc = c & 31, ob = rr * 64 + cc * 2; return st * 1024 + (ob ^ (((ob >> 9) & 1) << 5)); }
__host__ __device__ __forceinline__ void stage_rc(int b, int& R, int& C) { const int st = b / 1024, sb = b % 1024, swz = sb ^ (((sb >> 9) & 1) << 5); R = (st >> 1) * 16 + swz / 64; C = (st & 1) * 32 + (swz % 64) / 2; }
__host__ __device__ __forceinline__ int perm32(int rho) { const int n = rho >> 4, i = rho & 15; return 8 * (i >> 2) + 4 * n + (i & 3); }

struct Unit { int pm, pn; };
struct Gemm { const bf16_t* A; const bf16_t* Bt; int M, N, K; };

struct StaticOrder {
    int nM, nN, nwg, G, c;
    __host__ __device__ void init(int M, int N, int G_, int c_) { nM = M / BM; nN = N / BM; nwg = nM * nN; G = G_; c = c_; }
    __host__ __device__ bool next(int i, Unit& u) const {
        const long L = (long)i * G + c; if (L >= nwg) return false;
        int wgid = (int)L; { const int q = nwg / NXCD, r = nwg % NXCD, xcd = wgid % NXCD, off = wgid / NXCD; wgid = (xcd < r ? xcd * (q + 1) : r * (q + 1) + (xcd - r) * q) + off; }
        const int nig = WGM * nN, gid = wgid / nig, fm = gid * WGM, gsz = (nM - fm) < WGM ? (nM - fm) : WGM;
        u.pm = fm + ((wgid % nig) % gsz); u.pn = (wgid % nig) / gsz; return true;
    }
    __device__ __forceinline__ void a_ready(const Unit&) const {}
    __device__ __forceinline__ void done(const Unit&) const {}
};
__device__ __forceinline__ unsigned cvt_pk_bf16(float lo, float hi) { unsigned r; asm volatile("v_cvt_pk_bf16_f32 %0, %1, %2" : "=v"(r) : "v"(lo), "v"(hi)); return r; }
__device__ __forceinline__ float bf_lo(unsigned w) { return __uint_as_float(w << 16); }
__device__ __forceinline__ float bf_hi(unsigned w) { return __uint_as_float(w & 0xffff0000u); }
__device__ __forceinline__ float sigm(float x) { return __builtin_amdgcn_rcpf(1.0f + __builtin_amdgcn_exp2f(-x * LOG2E)); }
__device__ __forceinline__ u32x4 pack8(const f32x4 a, const f32x4 b) { u32x4 w; w.x = cvt_pk_bf16(a[0], a[1]); w.y = cvt_pk_bf16(a[2], a[3]); w.z = cvt_pk_bf16(b[0], b[1]); w.w = cvt_pk_bf16(b[2], b[3]); return w; }

struct EpiQKV {
    static constexpr bool PERM = true, AFTER_DRAIN = false, HAS_MID = false;
    bf16_t *QA, *KA, *VA, *QB, *KB, *VB; const float* cosT; const float* sinT;
    __device__ __forceinline__ void operator()(const f32x4 (&acc)[2][2][4][2], const Unit& u, int wr, int wc, int fr, int fq) const {
        const int type = u.pn >> 2;
        bf16_t* T = type == 0 ? QA : type == 1 ? KA : type == 2 ? VA : type == 3 ? QB : type == 4 ? KB : VB;
        const bool rope = type < 2; const float sc = type == 0 ? C2A : (type == 3 ? C2B : 1.0f);
        const int row0 = u.pm * BM + wr * 64 + fr, b = (u.pm * BM) >> 13, d = wc * 32 + 8 * fq, i0 = (wc & 1) * 16 + 4 * fq;
#pragma unroll
        for (int ai = 0; ai < 2; ++ai)
#pragma unroll
            for (int m = 0; m < 4; ++m) { const int row = row0 + ai * HALF + m * 16, s = row & (SEQ - 1);
                f32x4 c4 = {1.f, 1.f, 1.f, 1.f}, s4 = {0.f, 0.f, 0.f, 0.f};
                if (rope) { c4 = *(const f32x4*)(cosT + (size_t)row * 32 + i0); s4 = *(const f32x4*)(sinT + (size_t)row * 32 + i0); }
#pragma unroll
                for (int bj = 0; bj < 2; ++bj) { const int h = (u.pn & 3) * 2 + bj;
                    f32x4 v0 = acc[ai][bj][m][0], v1 = acc[ai][bj][m][1];
                    if (rope) { f32x4 r0, r1;
                        r0[0] = v0[0] * c4[0] - v0[1] * s4[0]; r0[1] = v0[0] * s4[0] + v0[1] * c4[0];
                        r0[2] = v0[2] * c4[1] - v0[3] * s4[1]; r0[3] = v0[2] * s4[1] + v0[3] * c4[1];
                        r1[0] = v1[0] * c4[2] - v1[1] * s4[2]; r1[1] = v1[0] * s4[2] + v1[1] * c4[2];
                        r1[2] = v1[2] * c4[3] - v1[3] * s4[3]; r1[3] = v1[2] * s4[3] + v1[3] * c4[3];
                        v0 = r0; v1 = r1; }
                    v0 = v0 * sc; v1 = v1 * sc;
                    *(u32x4*)(T + ((size_t)((b * NH + h) * SEQ + s)) * HD + d) = pack8(v0, v1); }
                if (m & 1) asm volatile("" ::: "memory"); }
    }
};
struct EpiGate {
    static constexpr bool PERM = true, AFTER_DRAIN = false, HAS_MID = false;
    const bf16_t *OA, *OB; bf16_t *G, *SA, *SB;
    __device__ __forceinline__ void operator()(const f32x4 (&acc)[2][2][4][2], const Unit& u, int wr, int wc, int fr, int fq) const {
        const int type = u.pn >> 2;
        const int row0 = u.pm * BM + wr * 64 + fr, b = (u.pm * BM) >> 13, d = wc * 32 + 8 * fq, n0 = (u.pn & 3) * 256 + d;
#pragma unroll
        for (int ai = 0; ai < 2; ++ai)
#pragma unroll
            for (int m = 0; m < 4; ++m) { const int row = row0 + ai * HALF + m * 16, s = row & (SEQ - 1);
#pragma unroll
                for (int bj = 0; bj < 2; ++bj) { const int h = (u.pn & 3) * 2 + bj, n = n0 + bj * HALF;
                    f32x4 v0 = acc[ai][bj][m][0], v1 = acc[ai][bj][m][1];
#pragma unroll
                    for (int j = 0; j < 4; ++j) { v0[j] = sigm(v0[j]); v1[j] = sigm(v1[j]); }
                    if (type < 2) { const bf16_t* O = type == 0 ? OA : OB;
                        const u32x4 ow = *(const u32x4*)(O + ((size_t)((b * NH + h) * SEQ + s)) * HD + d);
                        const f32x4 z0 = acc[ai][bj][m][0], z1 = acc[ai][bj][m][1];
                        v0[0] *= z0[0] * bf_lo(ow.x); v0[1] *= z0[1] * bf_hi(ow.x); v0[2] *= z0[2] * bf_lo(ow.y); v0[3] *= z0[3] * bf_hi(ow.y);
                        v1[0] *= z1[0] * bf_lo(ow.z); v1[1] *= z1[1] * bf_hi(ow.z); v1[2] *= z1[2] * bf_lo(ow.w); v1[3] *= z1[3] * bf_hi(ow.w);
                        *(u32x4*)(G + (size_t)row * 2048 + type * 1024 + n) = pack8(v0, v1); }
                    else { bf16_t* S_ = type == 2 ? SA : SB; *(u32x4*)(S_ + (size_t)row * 1024 + n) = pack8(v0, v1); } }
                asm volatile("" ::: "memory"); }
    }
};
struct EpiMerge {
    static constexpr bool PERM = true, AFTER_DRAIN = false, HAS_MID = true;
    const bf16_t *SA, *SB; bf16_t* MG;
    __device__ __forceinline__ void mid(f32x4 (&acc)[2][2][4][2], const Unit& u, int wr, int wc, int fr, int fq) const {
        int opq = 0; asm volatile("" : "+v"(opq));
        const int row0 = u.pm * BM + wr * 64 + fr + opq, c0 = u.pn * BM + wc * 32 + 8 * fq;
#pragma unroll
        for (int ai = 0; ai < 2; ++ai)
#pragma unroll
            for (int m = 0; m < 4; ++m) { const size_t ro = (size_t)(row0 + ai * HALF + m * 16) * 1024 + c0;
#pragma unroll
                for (int bj = 0; bj < 2; ++bj) { const u32x4 a = *(const u32x4*)(SA + ro + bj * HALF), bb = *(const u32x4*)(SB + ro + bj * HALF);
                    const float TINY = 8.6736174e-19f;
                    f32x4 r0, r1;
                    r0[0] = bf_lo(a.x) * __builtin_amdgcn_rcpf(fmaxf(bf_lo(bb.x), TINY)); r0[1] = bf_hi(a.x) * __builtin_amdgcn_rcpf(fmaxf(bf_hi(bb.x), TINY));
                    r0[2] = bf_lo(a.y) * __builtin_amdgcn_rcpf(fmaxf(bf_lo(bb.y), TINY)); r0[3] = bf_hi(a.y) * __builtin_amdgcn_rcpf(fmaxf(bf_hi(bb.y), TINY));
                    r1[0] = bf_lo(a.z) * __builtin_amdgcn_rcpf(fmaxf(bf_lo(bb.z), TINY)); r1[1] = bf_hi(a.z) * __builtin_amdgcn_rcpf(fmaxf(bf_hi(bb.z), TINY));
                    r1[2] = bf_lo(a.w) * __builtin_amdgcn_rcpf(fmaxf(bf_lo(bb.w), TINY)); r1[3] = bf_hi(a.w) * __builtin_amdgcn_rcpf(fmaxf(bf_hi(bb.w), TINY));
                    acc[ai][bj][m][0] = acc[ai][bj][m][0] * r0; acc[ai][bj][m][1] = acc[ai][bj][m][1] * r1; }
                asm volatile("" ::: "memory"); }
    }
    __device__ __forceinline__ void operator()(const f32x4 (&acc)[2][2][4][2], const Unit& u, int wr, int wc, int fr, int fq) const {
        const int row0 = u.pm * BM + wr * 64 + fr, c0 = u.pn * BM + wc * 32 + 8 * fq;
#pragma unroll
        for (int ai = 0; ai < 2; ++ai)
#pragma unroll
            for (int m = 0; m < 4; ++m) { const size_t ro = (size_t)(row0 + ai * HALF + m * 16) * 1024 + c0;
#pragma unroll
                for (int bj = 0; bj < 2; ++bj) { const u32x4 bb = *(const u32x4*)(SB + ro + bj * HALF);
                    const float TINY = 8.6736174e-19f;
                    f32x4 s0, s1;
                    s0[0] = fmaxf(bf_lo(bb.x), TINY); s0[1] = fmaxf(bf_hi(bb.x), TINY); s0[2] = fmaxf(bf_lo(bb.y), TINY); s0[3] = fmaxf(bf_hi(bb.y), TINY);
                    s1[0] = fmaxf(bf_lo(bb.z), TINY); s1[1] = fmaxf(bf_hi(bb.z), TINY); s1[2] = fmaxf(bf_lo(bb.w), TINY); s1[3] = fmaxf(bf_hi(bb.w), TINY);
                    *(u32x4*)(MG + ro + bj * HALF) = pack8(acc[ai][bj][m][0] * s0, acc[ai][bj][m][1] * s1); }
                asm volatile("" ::: "memory"); }
    }
};
struct EpiOut {
    static constexpr bool PERM = false, AFTER_DRAIN = false, HAS_MID = false;
    const float* x; float* out; const float* gate; float* PS;
    __device__ __forceinline__ void operator()(const f32x4 (&acc)[2][2][4][2], const Unit& u, int wr, int wc, int fr, int fq) const {
        const int row0 = u.pm * BM + wr * 64 + fr, b = (u.pm * BM) >> 13, col0 = u.pn * BM + wc * 32 + 4 * fq;
        f32x4 gv[2][2];
#pragma unroll
        for (int bj = 0; bj < 2; ++bj)
#pragma unroll
            for (int n = 0; n < 2; ++n) gv[bj][n] = *(const f32x4*)(gate + b * 1024 + col0 + bj * HALF + n * 16);
#pragma unroll
        for (int ai = 0; ai < 2; ++ai)
#pragma unroll
            for (int m = 0; m < 4; ++m) { const int row = row0 + ai * HALF + m * 16; const size_t ro = (size_t)row * 1024 + col0; float ss = 0.f;
#pragma unroll
                for (int bj = 0; bj < 2; ++bj)
#pragma unroll
                    for (int n = 0; n < 2; ++n) { const f32x4 xv = *(const f32x4*)(x + ro + bj * HALF + n * 16); const f32x4 o = xv + gv[bj][n] * acc[ai][bj][m][n];
                        ss += (o[0] * o[0] + o[1] * o[1]) + (o[2] * o[2] + o[3] * o[3]); *(f32x4*)(out + ro + bj * HALF + n * 16) = o; }
                ss += __shfl_xor(ss, 16); ss += __shfl_xor(ss, 32);
                if (fq == 0) PS[(size_t)row * 16 + u.pn * 4 + wc] = ss;
                if (m & 1) asm volatile("" ::: "memory"); }
    }
};

template <class Epi, class Sched, bool ALIGN_EPI = false, bool SP2 = false>
__device__ __forceinline__ void gemm_phase(PG8_LAS unsigned char* lds, const Gemm g, const Sched& S, const Epi& E) {
    const int tid = threadIdx.x, wid = __builtin_amdgcn_readfirstlane(tid >> 6), lane = tid & 63, wr = wid >> 2, wc = wid & 3, fr = lane & 15, fq = lane >> 4;
    const int K = g.K, nt = K / BK;
    unsigned voffA[2], voffB[2];
#pragma unroll
    for (int i = 0; i < 2; ++i) { int R, C; stage_rc(tid * 16 + i * 8192, R, C); const int Rb = Epi::PERM ? ((R & ~31) + perm32(R & 31)) : R;
        voffA[i] = (unsigned)(R * K + C) * 2u; voffB[i] = (unsigned)(Rb * K + C) * 2u; }
    const size_t kstep = (size_t)(BK * 2);
    const size_t hstep = (size_t)HALF * K * 2;
    const size_t tstep = 2 * hstep;
    const unsigned ldsw = (unsigned)wid * 1024u;
    const int aoff = lds_byte(wr * 64 + fr, fq * 8), boff = lds_byte(wc * 32 + fr, fq * 8);
#define PG8_SA(b, h) (((b) * 2 + (h)) * HTB)
#define PG8_SB(b, h) ((4 + (b) * 2 + (h)) * HTB)
#define PG8_STAGE(bufoff, gbase, voff) do { _Pragma("unroll") for (int _i = 0; _i < 2; ++_i) \
        __builtin_amdgcn_global_load_lds((const unsigned*)((const char*)(gbase) + (voff)[_i]), (PG8_LAS unsigned*)(lds + (bufoff) + ldsw + _i * 8192), 16, 0, 0); } while (0)
#define PG8_LDA(dst, b, h) do { _Pragma("unroll") for (int m = 0; m < 4; ++m) _Pragma("unroll") for (int k = 0; k < 2; ++k) dst[m][k] = *(const PG8_LAS bf16x8*)(lds + PG8_SA(b, h) + aoff + m * 2048 + k * 1024); } while (0)
#define PG8_LDB(dst, b, h) do { _Pragma("unroll") for (int n = 0; n < 2; ++n) _Pragma("unroll") for (int k = 0; k < 2; ++k) dst[n][k] = *(const PG8_LAS bf16x8*)(lds + PG8_SB(b, h) + boff + n * 2048 + k * 1024); } while (0)
#define PG8_MMA(ai, bj, At, Bt) do { __builtin_amdgcn_s_setprio(1); _Pragma("unroll") for (int m = 0; m < 4; ++m) _Pragma("unroll") for (int n = 0; n < 2; ++n) _Pragma("unroll") for (int k = 0; k < 2; ++k) \
        acc[ai][bj][m][n] = __builtin_amdgcn_mfma_f32_16x16x32_bf16(Bt[n][k], At[m][k], acc[ai][bj][m][n], 0, 0, 0); __builtin_amdgcn_s_setprio(0); } while (0)
#define PG8_WAIT_V(n) asm volatile("s_waitcnt vmcnt(" #n ")" ::: "memory")
#define PG8_WAIT_L(n) asm volatile("s_waitcnt lgkmcnt(" #n ")" ::: "memory")
#define PG8_BAR __builtin_amdgcn_s_barrier()
#define PG8_SCHED __builtin_amdgcn_sched_barrier(0)
    Unit cur, nxt; int ui = 0;
    if (!S.next(0, cur)) return;
    f32x4 acc[2][2][4][2];
#pragma unroll
    for (int a = 0; a < 2; ++a)
#pragma unroll
        for (int b = 0; b < 2; ++b)
#pragma unroll
            for (int m = 0; m < 4; ++m)
#pragma unroll
                for (int n = 0; n < 2; ++n) acc[a][b][m][n] = (f32x4){0.f, 0.f, 0.f, 0.f};
    bf16x8 At[4][2], B0[2][2], B1[2][2];
    const char* cA = (const char*)g.A + (size_t)cur.pm * tstep; const char* cB = (const char*)g.Bt + (size_t)cur.pn * tstep;
    S.a_ready(cur);
    if constexpr (SP2) {
        PG8_STAGE(PG8_SB(0, 0), cB, voffB); PG8_STAGE(PG8_SB(0, 1), cB + hstep, voffB); PG8_STAGE(PG8_SA(0, 0), cA, voffA); PG8_STAGE(PG8_SA(0, 1), cA + hstep, voffA);
        if (wr == 1) PG8_BAR;
        PG8_WAIT_V(2); PG8_BAR;
        PG8_STAGE(PG8_SB(1, 0), cB + kstep, voffB); PG8_STAGE(PG8_SA(1, 0), cA + kstep, voffA); PG8_STAGE(PG8_SB(1, 1), cB + hstep + kstep, voffB);
        PG8_WAIT_V(6); PG8_BAR;
    } else {
        PG8_STAGE(PG8_SB(0, 0), cB, voffB); PG8_STAGE(PG8_SA(0, 0), cA, voffA); PG8_STAGE(PG8_SB(0, 1), cB + hstep, voffB); PG8_STAGE(PG8_SA(0, 1), cA + hstep, voffA);
        if (wr == 1) PG8_BAR;
        PG8_WAIT_V(4); PG8_BAR;
        PG8_STAGE(PG8_SB(1, 0), cB + kstep, voffB); PG8_STAGE(PG8_SA(1, 0), cA + kstep, voffA); PG8_STAGE(PG8_SB(1, 1), cB + hstep + kstep, voffB);
        PG8_WAIT_V(6); PG8_BAR;
    }
    for (;;) {
        const bool has_next = S.next(ui + 1, nxt);
        const char* nA = has_next ? (const char*)g.A + (size_t)nxt.pm * tstep : cA; const char* nB = has_next ? (const char*)g.Bt + (size_t)nxt.pn * tstep : cB;
        for (int t = 0; t < nt; t += 2) {
            const bool last = (t == nt - 2);
            const char* a1 = cA + (size_t)(t + 1) * kstep;
            const char* a2 = last ? nA : cA + (size_t)(t + 2) * kstep; const char* b2 = last ? nB : cB + (size_t)(t + 2) * kstep;
            const char* a3 = a2 + kstep; const char* b3 = b2 + kstep;
            if (last && has_next) S.a_ready(nxt);
            if constexpr (SP2) {
            PG8_LDB(B0, 0, 0); PG8_LDB(B1, 0, 1); PG8_SCHED; PG8_LDA(At, 0, 0); PG8_STAGE(PG8_SA(1, 1), a1 + hstep, voffA);
            PG8_WAIT_V(8); PG8_WAIT_L(0); PG8_BAR; PG8_MMA(0, 0, At, B0); PG8_MMA(0, 1, At, B1); PG8_BAR; PG8_SCHED;
            PG8_LDA(At, 0, 1); PG8_STAGE(PG8_SB(0, 0), b2, voffB); PG8_STAGE(PG8_SB(0, 1), b2 + hstep, voffB); PG8_STAGE(PG8_SA(0, 0), a2, voffA);
            PG8_WAIT_V(8); PG8_WAIT_L(0); PG8_BAR; PG8_MMA(1, 0, At, B0); PG8_MMA(1, 1, At, B1); PG8_BAR; PG8_SCHED;
            PG8_LDB(B0, 1, 0); PG8_LDB(B1, 1, 1); PG8_SCHED; PG8_LDA(At, 1, 0); PG8_STAGE(PG8_SA(0, 1), a2 + hstep, voffA);
            PG8_WAIT_V(8); PG8_WAIT_L(0); PG8_BAR; PG8_MMA(0, 0, At, B0); PG8_MMA(0, 1, At, B1); PG8_BAR; PG8_SCHED;
            PG8_LDA(At, 1, 1); PG8_STAGE(PG8_SB(1, 0), b3, voffB); PG8_STAGE(PG8_SB(1, 1), b3 + hstep, voffB); PG8_STAGE(PG8_SA(1, 0), a3, voffA);
            PG8_WAIT_V(8); PG8_WAIT_L(0); PG8_BAR; PG8_MMA(1, 0, At, B0); PG8_MMA(1, 1, At, B1); PG8_BAR; PG8_SCHED;
            } else {
            PG8_LDB(B0, 0, 0); PG8_SCHED; PG8_LDA(At, 0, 0); PG8_STAGE(PG8_SA(1, 1), a1 + hstep, voffA);
            PG8_WAIT_L(8); PG8_BAR; PG8_WAIT_L(0); PG8_MMA(0, 0, At, B0); PG8_BAR; PG8_SCHED;
            PG8_LDB(B1, 0, 1); PG8_STAGE(PG8_SB(0, 0), b2, voffB);
            PG8_BAR; PG8_WAIT_L(0); PG8_MMA(0, 1, At, B1); PG8_BAR;
            PG8_LDA(At, 0, 1); PG8_STAGE(PG8_SA(0, 0), a2, voffA);
            PG8_BAR; PG8_WAIT_L(0); PG8_MMA(1, 0, At, B0); PG8_BAR; PG8_SCHED;
            PG8_STAGE(PG8_SB(0, 1), b2 + hstep, voffB);
            PG8_WAIT_V(6); PG8_BAR; PG8_MMA(1, 1, At, B1); PG8_BAR;
            PG8_LDB(B0, 1, 0); PG8_SCHED; PG8_LDA(At, 1, 0); PG8_STAGE(PG8_SA(0, 1), a2 + hstep, voffA);
            PG8_WAIT_L(8); PG8_BAR; PG8_WAIT_L(0); PG8_MMA(0, 0, At, B0); PG8_BAR; PG8_SCHED;
            PG8_LDB(B1, 1, 1); PG8_STAGE(PG8_SB(1, 0), b3, voffB);
            PG8_BAR; PG8_WAIT_L(0); PG8_MMA(0, 1, At, B1); PG8_BAR;
            PG8_LDA(At, 1, 1); PG8_STAGE(PG8_SA(1, 0), a3, voffA);
            PG8_BAR; PG8_WAIT_L(0); PG8_MMA(1, 0, At, B0); PG8_BAR; PG8_SCHED;
            PG8_STAGE(PG8_SB(1, 1), b3 + hstep, voffB);
            PG8_WAIT_V(6); PG8_BAR; PG8_MMA(1, 1, At, B1); PG8_BAR;
            }
            if constexpr (Epi::HAS_MID) { if (t + 2 == (nt >> 1)) E.mid(acc, cur, wr, wc, fr, fq); }
        }
        if constexpr (ALIGN_EPI) { if (wr == 0) PG8_BAR; }
        if constexpr (!Epi::AFTER_DRAIN) { E(acc, cur, wr, wc, fr, fq); S.done(cur); }
        if (!has_next) break;
#pragma unroll
        for (int a = 0; a < 2; ++a)
#pragma unroll
            for (int b = 0; b < 2; ++b)
#pragma unroll
                for (int m = 0; m < 4; ++m)
#pragma unroll
                    for (int n = 0; n < 2; ++n) acc[a][b][m][n] = (f32x4){0.f, 0.f, 0.f, 0.f};
        cur = nxt; cA = nA; cB = nB; ++ui;
        if constexpr (ALIGN_EPI) { if (wr == 1) PG8_BAR; }
    }
    PG8_WAIT_V(0);
    if constexpr (!ALIGN_EPI) { if (wr == 0) PG8_BAR; }
    PG8_BAR;
    if constexpr (Epi::AFTER_DRAIN) { E.fused(acc, cur, wr, wc, fr, fq, lds, wid, lane); S.done(cur); }
#undef PG8_SA
#undef PG8_SB
#undef PG8_STAGE
#undef PG8_LDA
#undef PG8_LDB
#undef PG8_MMA
#undef PG8_WAIT_V
#undef PG8_WAIT_L
#undef PG8_BAR
#undef PG8_SCHED
}
}

namespace att {
using bf16 = unsigned short;
typedef short bf16x8 __attribute__((ext_vector_type(8)));
typedef short s16x4 __attribute__((ext_vector_type(4)));
typedef float f32x16 __attribute__((ext_vector_type(16)));
typedef float f32x4 __attribute__((ext_vector_type(4)));
typedef unsigned u32x4 __attribute__((ext_vector_type(4)));
constexpr int D = 128, KVBLK = 64, SHM_V = KVBLK * D * 2, SHM_K = KVBLK * D * 2;
constexpr int OFF_V = 0, OFF_K = 2 * SHM_V, OFF_WS = OFF_K + 2 * SHM_K, OFF_FL = OFF_WS + 8 * 64 * 4, OFF_XCH = OFF_FL + 2 * 64 * 4, LDS_NEED = OFF_XCH + 4 * 64 * 64 * 4;
constexpr float THR2 = 8.0f * LOG2E;
#define KSWZ(row, colB) ((row) * 256 + ((colB) ^ (((row) & 7) << 4)))
#define SBAR() __builtin_amdgcn_sched_barrier(0)
__device__ __forceinline__ int v_st(int k, int c) { const int kk = (k & ~0xC) | ((k & 4) << 1) | ((k & 8) >> 1); return ((kk >> 3) * 4 + (c >> 5)) * 512 + ((kk & 7) * 32 + (c & 31)) * 2; }
__device__ __forceinline__ int v_rd_base(int lane) { return ((lane & 3) << 3) | (((lane >> 2) & 3) << 6) | (((lane >> 4) & 1) << 5) | (((lane >> 5) & 1) << 8); }
constexpr int v_rd_off(int d0, int ks, int half) { return d0 * 512 + ks * 4096 + half * 2048; }
__device__ __forceinline__ int crow(int r, int hi) { return (r & 3) + 8 * (r >> 2) + 4 * hi; }
__device__ __forceinline__ unsigned cvtpk(float lo, float hi) { unsigned r; asm volatile("v_cvt_pk_bf16_f32 %0, %1, %2" : "=v"(r) : "v"(lo), "v"(hi)); return r; }
__device__ __forceinline__ bf16x8 load8(const bf16* p) { return *reinterpret_cast<const bf16x8*>(p); }
__device__ __forceinline__ void mask_tile(f32x16& p0, f32x16& p1, int dq) {
    const float NEG = -__builtin_inff();
#pragma unroll
    for (int r = 0; r < 16; ++r) { const int c = (r & 3) + 8 * (r >> 2); if (dq - c < 0) p0[r] = NEG; if (dq - c - 32 < 0) p1[r] = NEG; }
}
__device__ __forceinline__ void partialSM(f32x16& p0, f32x16& p1, float& m_reg, float& mn, float& alpha) {
    float pmax = p0[0];
#pragma unroll
    for (int r = 1; r < 16; ++r) pmax = fmaxf(pmax, p0[r]);
#pragma unroll
    for (int r = 0; r < 16; ++r) pmax = fmaxf(pmax, p1[r]);
    { auto rr = __builtin_amdgcn_permlane32_swap(__float_as_uint(pmax), __float_as_uint(pmax), false, false);
      pmax = fmaxf(__uint_as_float(rr[0]), __uint_as_float(rr[1])); }
    if (__builtin_expect(__all((pmax - m_reg) <= THR2), 1)) { mn = m_reg; alpha = 1.f; }
    else { mn = fmaxf(m_reg, pmax); alpha = __builtin_amdgcn_exp2f(m_reg - mn); m_reg = mn; }
#pragma unroll
    for (int r = 0; r < 16; ++r) p0[r] = p0[r] - mn;
#pragma unroll
    for (int r = 0; r < 16; ++r) p1[r] = p1[r] - mn;
#pragma unroll
    for (int r = 0; r < 16; ++r) p0[r] = __builtin_amdgcn_exp2f(p0[r]);
}
__device__ __forceinline__ void finishSM(f32x16& p0, f32x16& p1, float alpha, float& l_reg, bf16x8& pa0, bf16x8& pa1, bf16x8& pa2, bf16x8& pa3) {
#pragma unroll
    for (int r = 0; r < 16; ++r) p1[r] = __builtin_amdgcn_exp2f(p1[r]);
    float ps = 0;
#pragma unroll
    for (int r = 0; r < 16; ++r) ps += p0[r];
#pragma unroll
    for (int r = 0; r < 16; ++r) ps += p1[r];
    { auto rr = __builtin_amdgcn_permlane32_swap(__float_as_uint(ps), __float_as_uint(ps), false, false);
      ps = __uint_as_float(rr[0]) + __uint_as_float(rr[1]); }
    l_reg = l_reg * alpha + ps;
#define PK4(P, B_, OUT) do { unsigned a0 = cvtpk(P[B_+0], P[B_+1]), a1 = cvtpk(P[B_+2], P[B_+3]);                          \
        unsigned b0 = cvtpk(P[B_+4], P[B_+5]), b1 = cvtpk(P[B_+6], P[B_+7]);                                             \
        auto r0 = __builtin_amdgcn_permlane32_swap(a0, b0, false, false); auto r1 = __builtin_amdgcn_permlane32_swap(a1, b1, false, false); \
        u32x4 w = {r0[0], r1[0], r0[1], r1[1]}; OUT = *reinterpret_cast<bf16x8*>(&w); } while (0)
    PK4(p0, 0, pa0); PK4(p0, 8, pa1); PK4(p1, 0, pa2); PK4(p1, 8, pa3);
#undef PK4
}
template <int KB, int MODE>
__device__ __forceinline__ void qkt(f32x16& p0, f32x16& p1, const char* K_lds, const float* Fl, int r32, int hi, const bf16x8* qr, const char* ql, bool act, int khalf) {
    if (!act) { const float NEG = -__builtin_inff();
#pragma unroll
        for (int r = 0; r < 16; ++r) { p0[r] = NEG; p1[r] = NEG; } return; }
    if constexpr (MODE == 1) { const float* gb = Fl + KB * 64 + 4 * hi;
#pragma unroll
        for (int g = 0; g < 4; ++g) { const f32x4 a = *(const f32x4*)(gb + 8 * g), b = *(const f32x4*)(gb + 32 + 8 * g);
            p0[4 * g] = a[0]; p0[4 * g + 1] = a[1]; p0[4 * g + 2] = a[2]; p0[4 * g + 3] = a[3];
            p1[4 * g] = b[0]; p1[4 * g + 1] = b[1]; p1[4 * g + 2] = b[2]; p1[4 * g + 3] = b[3]; } }
    else { p0 = f32x16{}; p1 = f32x16{}; }
    const char* kb[4];
#pragma unroll
    for (int dd = 0; dd < 4; ++dd) kb[dd] = K_lds + KB * SHM_K + KSWZ(r32, (dd * 16 + hi * 8) * 2);
    if constexpr (MODE == 1) {
#pragma unroll
        for (int d0 = 0; d0 < 8; ++d0) { const char* a = kb[d0 & 3] + (d0 >> 2) * 128;
            bf16x8 b0 = *reinterpret_cast<const bf16x8*>(a);
            bf16x8 b1 = *reinterpret_cast<const bf16x8*>(a + 32 * 256);
            const bf16x8 q = *reinterpret_cast<const bf16x8*>(ql + d0 * 1024);
            p0 = __builtin_amdgcn_mfma_f32_32x32x16_bf16(b0, q, p0, 0, 0, 0);
            p1 = __builtin_amdgcn_mfma_f32_32x32x16_bf16(b1, q, p1, 0, 0, 0); }
    } else {
#pragma unroll
        for (int d0 = 0; d0 < 4; ++d0) { const char* a = kb[d0] + khalf * 128;
            bf16x8 b0 = *reinterpret_cast<const bf16x8*>(a);
            bf16x8 b1 = *reinterpret_cast<const bf16x8*>(a + 32 * 256);
            p0 = __builtin_amdgcn_mfma_f32_32x32x16_bf16(b0, qr[d0], p0, 0, 0, 0);
            p1 = __builtin_amdgcn_mfma_f32_32x32x16_bf16(b1, qr[d0], p1, 0, 0, 0); }
    }
}
template <int VB>
__device__ __forceinline__ void pv_tile(f32x16* o, int vb0, bf16x8 pa0, bf16x8 pa1, bf16x8 pa2, bf16x8 pa3, bool act) {
    if (!act) return;
#define TRRD(dst, off) asm volatile("ds_read_b64_tr_b16 %0, %1 offset:%2" : "=&v"(dst) : "v"(vb0), "i"(off) : "memory")
#define PV_D0(d0) do { s16x4 l0, l1, l2, l3, h0, h1, h2, h3; constexpr int b_ = OFF_V + VB * SHM_V + v_rd_off(d0, 0, 0);   \
        TRRD(l0, b_); TRRD(h0, b_ + 2048); TRRD(l1, b_ + 4096); TRRD(h1, b_ + 6144); TRRD(l2, b_ + 8192); TRRD(h2, b_ + 10240); TRRD(l3, b_ + 12288); TRRD(h3, b_ + 14336); \
        asm volatile("s_waitcnt lgkmcnt(0)" ::: "memory"); SBAR();   \
        o[d0] = __builtin_amdgcn_mfma_f32_32x32x16_bf16(pa0, (bf16x8){l0[0], l0[1], l0[2], l0[3], h0[0], h0[1], h0[2], h0[3]}, o[d0], 0, 0, 0);   \
        o[d0] = __builtin_amdgcn_mfma_f32_32x32x16_bf16(pa1, (bf16x8){l1[0], l1[1], l1[2], l1[3], h1[0], h1[1], h1[2], h1[3]}, o[d0], 0, 0, 0);   \
        o[d0] = __builtin_amdgcn_mfma_f32_32x32x16_bf16(pa2, (bf16x8){l2[0], l2[1], l2[2], l2[3], h2[0], h2[1], h2[2], h2[3]}, o[d0], 0, 0, 0);   \
        o[d0] = __builtin_amdgcn_mfma_f32_32x32x16_bf16(pa3, (bf16x8){l3[0], l3[1], l3[2], l3[3], h3[0], h3[1], h3[2], h3[3]}, o[d0], 0, 0, 0); } while (0)
    PV_D0(0); PV_D0(1); PV_D0(2); PV_D0(3);
#undef PV_D0
#undef TRRD
}
struct BlockRef { const bf16* Q; const bf16* K; const bf16* V; bf16* O; const float* F; int P0; };
struct Seam { bf16x8 qr[8]; bf16x8 st_v0, st_v1, st_k0, st_k1; float st_f; };
__device__ __forceinline__ float ld_agent(const float* p) { return __uint_as_float((unsigned)__builtin_amdgcn_readfirstlane((int)__float_as_uint(__hip_atomic_load(p, __ATOMIC_RELAXED, __HIP_MEMORY_SCOPE_AGENT)))); }
#define ROW(p, k0, rr) ((p) + (size_t)((k0) + (rr)) * D + sc)
#define VMW() asm volatile("s_waitcnt vmcnt(0)" ::: "memory")
#define VMWN(n) asm volatile("s_waitcnt vmcnt(%0)" :: "i"(n) : "memory")
#define SLOADX(Kp, Vp, Fp, k0) do { S.st_v0 = load8(ROW(Vp, k0, sr)); S.st_v1 = load8(ROW(Vp, k0, 32 + sr));              \
                         S.st_k0 = load8(ROW(Kp, k0, sr)); S.st_k1 = load8(ROW(Kp, k0, 32 + sr));                          \
                         if (MODE == 1 && wid == 0) S.st_f = (Fp)[(k0) + lane]; } while (0)
#define SWRITE_HK(bf, fr_) do { *(bf16x8*)(K_lds + (bf) * SHM_K + kws) = S.st_k0; *(bf16x8*)(K_lds + (bf) * SHM_K + kws + 32 * 256) = S.st_k1; \
                         if (MODE == 1 && wid == 0) Fl[(bf) * 64 + lane] = ((fr_) - S.st_f) * LOG2E; } while (0)
#define SWRITE_HV(bf) do { *(bf16x8*)(V_lds + (bf) * SHM_V + vst0) = S.st_v0; *(bf16x8*)(V_lds + (bf) * SHM_V + vst1) = S.st_v1; } while (0)
template <int MODE>
__device__ __forceinline__ void attn_prime(const BlockRef& cur, char* lds, Seam& S) {
    constexpr int QROWS = MODE == 0 ? 128 : 256;
    const int tid = threadIdx.x, wid = __builtin_amdgcn_readfirstlane(tid >> 6), lane = tid & 63, r32 = lane & 31, hi = lane >> 5;
    const int sr = tid >> 4, sc = (tid & 15) * 8, kws = KSWZ(sr, sc * 2); char* K_lds = lds + OFF_K; float* Fl = (float*)(lds + OFF_FL);
    const int kb0 = ((cur.P0 + QROWS - 1) / KVBLK) * KVBLK;
    if constexpr (MODE == 0) {
#pragma unroll
        for (int d0 = 0; d0 < 4; ++d0) S.qr[d0] = load8(cur.Q + (size_t)((wid & 3) * 32 + r32) * D + (wid >> 2) * 64 + d0 * 16 + hi * 8);
    } else {
#pragma unroll
        for (int d0 = 0; d0 < 8; ++d0) S.qr[d0] = load8(cur.Q + (size_t)(wid * 32 + r32) * D + d0 * 16 + hi * 8);
    }
    float fref = 0.f; if constexpr (MODE == 1) fref = ld_agent(cur.F + cur.P0);
    SLOADX(cur.K, cur.V, cur.F, kb0); VMW(); SWRITE_HK(0, fref);
    __syncthreads();
}
template <int MODE>
__device__ __forceinline__ void attn_block(const BlockRef& cur, const BlockRef& nxt, float lam, const float* gsub, char* lds, Seam& S) {
    constexpr int QROWS = MODE == 0 ? 128 : 256, NQL = MODE == 0 ? 4 : 8;
    const int tid = threadIdx.x, wid = __builtin_amdgcn_readfirstlane(tid >> 6), lane = tid & 63, r32 = lane & 31, hi = lane >> 5;
    const int jl = (cur.P0 + QROWS - 1) / KVBLK, NT = jl + 1;
    const int kbn = ((nxt.P0 + QROWS - 1) / KVBLK) * KVBLK;
    const int wrow = MODE == 0 ? (wid & 3) * 32 : wid * 32, khalf = MODE == 0 ? (wid >> 2) : 0;
    const int qlo = cur.P0 + wrow, qm = qlo + r32 - 4 * hi;
    char* V_lds = lds + OFF_V; char* K_lds = lds + OFF_K;
    float* ws = (float*)(lds + OFF_WS) + wid * 64; float* li_l = ws, * al_l = ws + 32; float* Fl = (float*)(lds + OFF_FL);
    float m_reg = -1e30f, l_reg = 0; f32x16 o[4] = {};
    const int sr = tid >> 4, sc = (tid & 15) * 8, vst0 = v_st(sr, sc), vst1 = v_st(32 + sr, sc), kws = KSWZ(sr, sc * 2);
    const int vb0 = (int)(uintptr_t)lds + v_rd_base(lane);
    const bf16* Kh = cur.K; const bf16* Vh = cur.V; const float* Fh = cur.F;
    float fref = 0.f, frefn = 0.f;
    if constexpr (MODE == 1) { fref = ld_agent(cur.F + cur.P0); frefn = ld_agent(nxt.F + nxt.P0); }
#define RESC(a) do { if (__any((a) < 1.f)) { if (hi == 0) al_l[r32] = (a); asm volatile("s_waitcnt lgkmcnt(0)" ::: "memory");              \
                     for (int d_ = 0; d_ < 4; ++d_) for (int r = 0; r < 16; ++r) o[d_][r] *= al_l[crow(r, hi)]; } } while (0)
#define KBASE(t) ((jl - (t)) * KVBLK)
#define ACT(t) (KBASE(t) <= qlo + (MODE == 0 ? 0 : 31))
#define MASKT(P0_, P1_, t) do { if constexpr (MODE == 1) { const int kb_ = KBASE(t); if (ACT(t) && kb_ + KVBLK - 1 > qlo) mask_tile(P0_, P1_, qm - kb_); } } while (0)
#define SEAM_K0() do { VMWN(NQL); SWRITE_HK(0, frefn); SBAR(); } while (0)
    f32x16 pA0, pA1, pB0, pB1; float mnA, mnB, alA, alB; bf16x8 pa0, pa1, pa2, pa3;
    const char* ql = lds + OFF_XCH + wid * 8192 + lane * 16;
    if constexpr (MODE == 1) {
#pragma unroll
        for (int d0 = 0; d0 < 8; ++d0) *(bf16x8*)(lds + OFF_XCH + wid * 8192 + d0 * 1024 + lane * 16) = S.qr[d0];
    }
    SWRITE_HV(0); SBAR();
    if (NT > 1) { SLOADX(Kh, Vh, Fh, KBASE(1)); }
    SBAR(); qkt<0, MODE>(pA0, pA1, K_lds, Fl, r32, hi, S.qr, ql, ACT(0), khalf);
    MASKT(pA0, pA1, 0); partialSM(pA0, pA1, m_reg, mnA, alA);
    if (NT > 1) { VMW(); SWRITE_HV(1); SWRITE_HK(1, fref); }
    __syncthreads();
#define HALF_STEP(PX0, PX1, mnX, alX, PY0, PY1, alY, t, KB, VB, SB) do {                                                      \
        SBAR(); qkt<KB, MODE>(PX0, PX1, K_lds, Fl, r32, hi, S.qr, ql, ACT(t), khalf);                                            \
        finishSM(PY0, PY1, alY, l_reg, pa0, pa1, pa2, pa3); SBAR();                                                           \
        if ((t) + 1 < NT) { SLOADX(Kh, Vh, Fh, KBASE((t) + 1)); SBAR(); }                                                     \
        pv_tile<VB>(o, vb0, pa0, pa1, pa2, pa3, ACT((t) - 1)); MASKT(PX0, PX1, (t)); partialSM(PX0, PX1, m_reg, mnX, alX);    \
        __syncthreads();                                                                                                      \
        if ((t) + 1 < NT) { VMW(); SWRITE_HV(SB); SWRITE_HK(SB, fref); }                                                      \
        RESC(alX); __syncthreads(); } while (0)
    for (int t = 1; t + 1 < NT; t += 2) {
        HALF_STEP(pB0, pB1, mnB, alB, pA0, pA1, alA, t, 1, 0, 0);
        HALF_STEP(pA0, pA1, mnA, alA, pB0, pB1, alB, t + 1, 0, 1, 1);
    }
    const bool even = (NT & 1) == 0;
    if (even) { SBAR(); qkt<1, MODE>(pB0, pB1, K_lds, Fl, r32, hi, S.qr, ql, ACT(NT - 1), khalf); SBAR(); }
    SLOADX(nxt.K, nxt.V, nxt.F, kbn); SBAR();
    if constexpr (MODE == 0) {
#pragma unroll
        for (int d0 = 0; d0 < 4; ++d0) S.qr[d0] = load8(nxt.Q + (size_t)((wid & 3) * 32 + r32) * D + (wid >> 2) * 64 + d0 * 16 + hi * 8);
    } else {
#pragma unroll
        for (int d0 = 0; d0 < 8; ++d0) S.qr[d0] = load8(nxt.Q + (size_t)(wid * 32 + r32) * D + d0 * 16 + hi * 8);
    }
    SBAR();
    finishSM(pA0, pA1, alA, l_reg, pa0, pa1, pa2, pa3); SBAR();
    pv_tile<0>(o, vb0, pa0, pa1, pa2, pa3, ACT(even ? NT - 2 : NT - 1));
    if (even) { MASKT(pB0, pB1, NT - 1); partialSM(pB0, pB1, m_reg, mnB, alB); __syncthreads(); RESC(alB);
        finishSM(pB0, pB1, alB, l_reg, pa0, pa1, pa2, pa3); SBAR(); pv_tile<1>(o, vb0, pa0, pa1, pa2, pa3, ACT(NT - 1)); }
    SBAR(); SEAM_K0();
    if (hi == 0) li_l[r32] = l_reg; asm volatile("s_waitcnt lgkmcnt(0)" ::: "memory");
    float rli[16];
#pragma unroll
    for (int r = 0; r < 16; ++r) rli[r] = __builtin_amdgcn_rcpf(li_l[crow(r, hi)]);
    bf16* Ow = cur.O + (size_t)wrow * D;
    if constexpr (MODE == 0) {
        float* xch = (float*)(lds + OFF_XCH) + (wid & 3) * 4096 + lane;
        if (wid >= 4) {
#pragma unroll
            for (int d0 = 0; d0 < 4; ++d0)
#pragma unroll
                for (int r = 0; r < 16; ++r) xch[(d0 * 16 + r) * 64] = o[d0][r] * rli[r];
        }
        __syncthreads();
        if (wid < 4) {
            float ss[16];
#pragma unroll
            for (int r = 0; r < 16; ++r) { float a = 0.f;
#pragma unroll
                for (int d0 = 0; d0 < 4; ++d0) { const float v = o[d0][r] * rli[r] - lam * xch[(d0 * 16 + r) * 64]; o[d0][r] = v; a += v * v; }
                ss[r] = a; }
#pragma unroll
            for (int r = 0; r < 16; ++r) { float a = ss[r]; a += __shfl_xor(a, 1); a += __shfl_xor(a, 2); a += __shfl_xor(a, 4); a += __shfl_xor(a, 8); a += __shfl_xor(a, 16); ss[r] = a; }
            float g4[4];
#pragma unroll
            for (int d0 = 0; d0 < 4; ++d0) g4[d0] = gsub[d0 * 32 + r32] * 0.8f;
#pragma unroll
            for (int r = 0; r < 16; ++r) { const int orow = crow(r, hi); const float rstd = 1.0f / sqrtf(ss[r] * (1.0f / 128.0f) + 1e-5f);
#pragma unroll
                for (int d0 = 0; d0 < 4; ++d0) { const float v = o[d0][r] * rstd * g4[d0]; const float vn = __shfl_xor(v, 1);
                    if ((r32 & 1) == 0) *(unsigned*)(Ow + (size_t)orow * D + d0 * 32 + r32) = cvtpk(v, vn); } }
        }
    } else {
#pragma unroll
        for (int r = 0; r < 16; ++r) { const int orow = crow(r, hi);
#pragma unroll
            for (int d0 = 0; d0 < 4; ++d0) { const float v = o[d0][r] * rli[r]; const float vn = __shfl_xor(v, 1);
                if ((r32 & 1) == 0) *(unsigned*)(Ow + (size_t)orow * D + d0 * 32 + r32) = cvtpk(v, vn); } }
    }
    __syncthreads();
#undef RESC
#undef KBASE
#undef ACT
#undef MASKT
#undef SEAM_K0
#undef HALF_STEP
}
#undef ROW
#undef VMW
#undef VMWN
#undef SLOADX
#undef SWRITE_HK
#undef SWRITE_HV
#undef SBAR
#undef KSWZ
}

constexpr int NWAVES = 8;
#ifndef MK_N_LAUNCHES
#define MK_N_LAUNCHES 1
#endif
constexpr int PER_PHASE = 8;
constexpr int N_LAUNCHES = MK_N_LAUNCHES;

constexpr size_t MiB = 1u << 20;
constexpr size_t WS_CTL = 0, CTL_ZERO_BYTES = 1 * MiB;
constexpr size_t WS_WQKV = 1 * MiB;
constexpr size_t WS_WG = 13 * MiB;
constexpr size_t WS_WAB = 21 * MiB;
constexpr size_t WS_WO = 25 * MiB;
constexpr size_t WS_COS = 27 * MiB, WS_SIN = 29 * MiB;
constexpr size_t WS_LOGF = 31 * MiB;
constexpr size_t WS_CUMF = 31 * MiB + 512 * 1024;
constexpr size_t WS_MODP = 32 * MiB;
constexpr size_t WS_GATE = 32 * MiB + 512 * 1024;
constexpr size_t WS_PS = 33 * MiB;
constexpr size_t WS_XN = 34 * MiB;
constexpr size_t WS_QA = 66 * MiB, WS_KA = 98 * MiB, WS_VA = 130 * MiB, WS_QB = 162 * MiB, WS_X5 = 194 * MiB, WS_END = 226 * MiB;
constexpr size_t WS_G = WS_KA;
constexpr size_t WS_SA = WS_X5;
constexpr int CW_TMO = 0, CW_CODE = 1, CW_BAR = 4096, CW_Q = 8192;

constexpr int RING_OFF = 0, RING_BYTES = 135168;
constexpr int LDSCTL_OFF = RING_BYTES, MISC_OFF = LDSCTL_OFF + 320;
constexpr int LDS_BYTES = 147456;
static_assert(MISC_OFF + 128 <= LDS_BYTES && att::LDS_NEED <= RING_BYTES && pg8::STAGE_BYTES <= RING_BYTES, "LDS map");

#define GAS __attribute__((address_space(1)))
#define LAS __attribute__((address_space(3)))
typedef unsigned short bf16;
typedef unsigned v4u __attribute__((ext_vector_type(4)));
typedef float f32x4 __attribute__((ext_vector_type(4)));
typedef short bf16x8 __attribute__((ext_vector_type(8)));
typedef GAS unsigned gu32;
typedef GAS unsigned long long gu64;
#define RLX_AGENT __ATOMIC_RELAXED, __HIP_MEMORY_SCOPE_AGENT
#define LDS_WAIT() asm volatile("s_waitcnt lgkmcnt(0)" ::: "memory")
#define VM_WAIT() asm volatile("s_waitcnt vmcnt(0)" ::: "memory")
__device__ __forceinline__ unsigned long long rt() { return __builtin_amdgcn_s_memrealtime(); }
__device__ __forceinline__ unsigned f2bf(float f) { unsigned u = __builtin_bit_cast(unsigned, f); return (u + 0x7fffu + ((u >> 16) & 1u)) >> 16; }
__device__ __forceinline__ unsigned pk2(float lo, float hi) { return f2bf(lo) | (f2bf(hi) << 16); }

#define XB_TMO      128
#define XB_XCNT(j)  (256  + 64 * (j))
#define XB_XSUB(j)  (1280 + 64 * (j))
#define XB_XGEN(j)  (2304 + 64 * (j))
#define XB_TOP      3328
#define XB_TOPGEN   3392
#define XCD_BAR_WORDS 3456
#define XB_SPIN_CAP (1u << 18)

__device__ __forceinline__ unsigned xb_ld(unsigned* p)              { return __hip_atomic_load(p, __ATOMIC_RELAXED, __HIP_MEMORY_SCOPE_AGENT); }
__device__ __forceinline__ unsigned xb_add(unsigned* p, unsigned v) { return __hip_atomic_fetch_add(p, v, __ATOMIC_RELAXED, __HIP_MEMORY_SCOPE_AGENT); }
__device__ __forceinline__ unsigned xb_xcc_id() { return (unsigned)__builtin_amdgcn_s_getreg((3 << 11) | 20) & 0xFu; }
#define XB_SPIN(cond, bar) do { unsigned _sp = 0; while (cond) { __builtin_amdgcn_s_sleep(1); \
    if ((++_sp & 255u) == 0u) { if (xb_ld(&(bar)[XB_TMO])) break; if (_sp > XB_SPIN_CAP) { atomicAdd(&(bar)[XB_TMO], 1u); break; } } } } while (0)

struct XcdBarrier {
    unsigned* bar; unsigned x;
    volatile LAS unsigned* st;
};

__device__ __forceinline__ XcdBarrier xcd_barrier_post(unsigned* bar, volatile LAS unsigned* st) {
    XcdBarrier b; b.bar = bar; b.x = xb_xcc_id(); b.st = st;
    if (threadIdx.x == 0) (void)xb_add(&bar[XB_XCNT(b.x)], 1u);
    return b;
}
__device__ __forceinline__ void xcd_barrier_complete(unsigned* bar, unsigned x, unsigned& nloc, unsigned& nx) {
    const unsigned G = gridDim.x * gridDim.y * gridDim.z;
    unsigned sum, cnt, mine, sp = 0u;
    for (;;) {
        sum = 0u; cnt = 0u; mine = 0u;
#pragma unroll
        for (unsigned j = 0; j < 16; ++j) { const unsigned c = xb_ld(&bar[XB_XCNT(j)]); sum += c; cnt += (c > 0u) ? 1u : 0u; mine = (j == x) ? c : mine; }
        if (sum == G) break;
        __builtin_amdgcn_s_sleep(1);
        if ((++sp & 255u) == 0u) { if (xb_ld(&bar[XB_TMO])) break; if (sp > XB_SPIN_CAP) { atomicAdd(&bar[XB_TMO], 1u); break; } }
    }
    nloc = mine > 0u ? mine : 1u; nx = cnt > 0u ? cnt : 1u;
}

__device__ __forceinline__ void xcd_barrier(const XcdBarrier& b) {
    asm volatile("s_waitcnt vmcnt(0)" ::: "memory");
    __syncthreads();
    if (threadIdx.x == 0) {
        unsigned* bar = b.bar;
        __builtin_amdgcn_s_waitcnt(0);
        unsigned nloc = b.st[0], nx = b.st[1];
        if (nloc == 0u) { xcd_barrier_complete(bar, b.x, nloc, nx); b.st[0] = nloc; b.st[1] = nx; }
        const unsigned old = xb_add(&bar[XB_XSUB(b.x)], 1u);
        const unsigned gen = old / nloc;
        if (old + 1u == (gen + 1u) * nloc) {
            __builtin_amdgcn_fence(__ATOMIC_RELEASE, "agent");
            asm volatile("s_waitcnt vmcnt(0)" ::: "memory");
            const unsigned og = xb_add(&bar[XB_TOP], 1u);
            const unsigned tg = og / nx;
            if (og + 1u == (tg + 1u) * nx) xb_add(&bar[XB_TOPGEN], 1u);
            else XB_SPIN(xb_ld(&bar[XB_TOPGEN]) == tg, bar);
            __builtin_amdgcn_fence(__ATOMIC_ACQUIRE, "agent");
            xb_add(&bar[XB_XGEN(b.x)], 1u);
            asm volatile("s_waitcnt vmcnt(0)" ::: "memory");
        } else {
            XB_SPIN(xb_ld(&bar[XB_XGEN(b.x)]) == gen, bar);
            __builtin_amdgcn_fence(__ATOMIC_ACQUIRE, "agent");
            asm volatile("s_waitcnt vmcnt(0)" ::: "memory");
        }
    }
    __syncthreads();
}

struct Frame {
    LAS unsigned char* lds;
    volatile LAS unsigned* MISC;
    gu32* ctl;
    int tid, lane, wave;
    int vcu, G;
};
__device__ __forceinline__ float wave_sum(float v) {
#pragma unroll
    for (int o = 1; o < 64; o <<= 1) v += __shfl_xor(v, o);
    return v;
}
__device__ const float INV_FREQ[32] = {
    1.000000000e+00f, 7.498942018e-01f, 5.623413324e-01f, 4.216965139e-01f, 3.162277639e-01f, 2.371373773e-01f, 1.778279394e-01f, 1.333521456e-01f, 1.000000015e-01f, 7.498942316e-02f, 5.623413250e-02f, 4.216964915e-02f, 3.162277490e-02f, 2.371373773e-02f, 1.778279431e-02f, 1.333521400e-02f, 9.999999776e-03f, 7.498942316e-03f, 5.623413250e-03f, 4.216964822e-03f, 3.162277630e-03f, 2.371373819e-03f, 1.778279431e-03f, 1.333521446e-03f, 1.000000047e-03f, 7.498941850e-04f, 5.623413017e-04f, 4.216965172e-04f, 3.162277571e-04f, 2.371373703e-04f, 1.778279402e-04f, 1.333521504e-04f };
__device__ __forceinline__ void sincos_d(float angf, float& c, float& s) {
    const double a = (double)angf;
    const double k = __builtin_rint(a * 0.63661977236758134308);
    double r = __builtin_fma(-k, 1.57079632679489655800e+00, a); r = __builtin_fma(-k, 6.12323399573676603587e-17, r);
    const double r2 = r * r;
    double sp = -7.6471637318198164759e-13; sp = sp * r2 + 1.6059043836821614599e-10; sp = sp * r2 - 2.5052108385441718775e-08; sp = sp * r2 + 2.7557319223985890653e-06;
    sp = sp * r2 - 1.9841269841269841270e-04; sp = sp * r2 + 8.3333333333333333333e-03; sp = sp * r2 - 1.6666666666666666667e-01; const double sn = r + r * r2 * sp;
    double cp = 4.7794773323873852974e-14; cp = cp * r2 - 1.1470745597729724714e-11; cp = cp * r2 + 2.0876756987868098979e-09; cp = cp * r2 - 2.7557319223985890653e-07;
    cp = cp * r2 + 2.4801587301587301587e-05; cp = cp * r2 - 1.3888888888888888889e-03; cp = cp * r2 + 4.1666666666666666667e-02; cp = cp * r2 - 0.5; const double cs = 1.0 + r2 * cp;
    const int q = ((int)(long long)k) & 3;
    const double sv = (q == 0) ? sn : (q == 1) ? cs : (q == 2) ? -sn : -cs;
    const double cv = (q == 0) ? cs : (q == 1) ? -sn : (q == 2) ? -cs : sn;
    c = (float)cv; s = (float)sv;
}
__device__ __forceinline__ void p0_tr_item(const float* W, int ldw, int dst_pitch, int dst_koff, bf16* WT, int mode, LAS float* scr, int item, int nblk, int lane) {
    const int kb = item / nblk, nb = item % nblk, k0 = 64 * kb, n0 = 32 * nb;
    const int nn = n0 + (lane & 31); int sc = nn;
    if (mode == 1) { const int type = nn >> 10, j = nn & 1023, sblk = type < 3 ? type : type + 1; int jj = j;
        if (type < 2) { const int g = j >> 6, p = j & 63; jj = g * 64 + (p & 1) * 32 + (p >> 1); }
        sc = sblk * 1024 + jj; }
    else if (mode == 2) { const int type = nn >> 10, j = nn & 1023; sc = type == 0 ? 3 * 1024 + j : type == 1 ? 7 * 1024 + j : type == 2 ? 8200 + j : 9224 + j; }
#pragma unroll 8
    for (int i = 0; i < 32; ++i) { const int kk = 2 * i + (lane >> 5); scr[kk * 33 + (lane & 31)] = W[(size_t)(k0 + kk) * ldw + sc]; }
    LDS_WAIT(); asm volatile("" ::: "memory");
    const int c = lane & 7;
#pragma unroll
    for (int j = 0; j < 4; ++j) { const int n = (lane >> 3) + 8 * j; const LAS float* s = scr + (8 * c) * 33 + n;
        v4u o; o.x = pk2(s[0 * 33], s[1 * 33]); o.y = pk2(s[2 * 33], s[3 * 33]); o.z = pk2(s[4 * 33], s[5 * 33]); o.w = pk2(s[6 * 33], s[7 * 33]);
        *(GAS v4u*)(WT + (size_t)(n0 + n) * dst_pitch + dst_koff + k0 + 8 * c) = o; }
    LDS_WAIT(); asm volatile("" ::: "memory");
}
struct Args { const float* x; const float* c; const int* pos; const float* w_ada; const float* b_ada; const float* g_norm; const float* w_in; const float* b_forget;
              const float* lq1; const float* lk1; const float* lq2; const float* lk2; const float* g_subln; const float* w_a; const float* w_b; const float* w_out; const float* g_final;
              float* out; unsigned char* ws; int ph_lo, ph_hi, li, pad; };

__global__ void __launch_bounds__(NWAVES * 64, 2) fwd_kernel(Args args) {
    extern __shared__ __attribute__((aligned(16))) unsigned char lds[];
    Frame F;
    F.lds = (LAS unsigned char*)lds;
    F.MISC = (volatile LAS unsigned*)(F.lds + MISC_OFF);
    F.tid = threadIdx.x; F.lane = F.tid & 63; F.wave = __builtin_amdgcn_readfirstlane(F.tid >> 6);
    F.G = gridDim.x; { const int bx = blockIdx.x; F.vcu = (F.G % 8 == 0) ? (bx % 8) * (F.G / 8) + bx / 8 : bx; }
    unsigned char* ws = args.ws;
    F.ctl = (gu32*)(ws + WS_CTL);
    for (int u = F.tid; u < (LDS_BYTES - LDSCTL_OFF) / 4; u += NWAVES * 64) ((LAS unsigned*)(F.lds + LDSCTL_OFF))[u] = 0u;
    __syncthreads();
    XcdBarrier bar; bar.bar = (unsigned*)(F.ctl + CW_BAR); bar.x = 0; bar.st = nullptr;
    if (N_LAUNCHES != PER_PHASE) bar = xcd_barrier_post((unsigned*)(F.ctl + CW_BAR), F.MISC + 8);
#define GRID_BAR(seam) do { if (N_LAUNCHES == PER_PHASE) { if (F.tid == 0) __hip_atomic_store(F.ctl + CW_TMO, 0xBADBA0u | (unsigned)(seam), RLX_AGENT); } else { xcd_barrier(bar); } } while (0)
    const int lo = args.ph_lo, hi = args.ph_hi;
#ifndef PHASE_MASK
#define PHASE_MASK 0xff
#endif
#define IN(k) (((PHASE_MASK >> (k)) & 1) && lo <= (k) && (k) < hi)
#define BOTH(k) (IN(k) && IN((k) + 1))
    bf16* const WQKV_T = (bf16*)(ws + WS_WQKV); bf16* const WG_T = (bf16*)(ws + WS_WG); bf16* const WAB_T = (bf16*)(ws + WS_WAB); bf16* const WO_T = (bf16*)(ws + WS_WO);
    float* const COS_T = (float*)(ws + WS_COS); float* const SIN_T = (float*)(ws + WS_SIN); float* const LOGF = (float*)(ws + WS_LOGF); float* const CUMF = (float*)(ws + WS_CUMF);
    float* const MODP = (float*)(ws + WS_MODP); float* const GATE = (float*)(ws + WS_GATE); float* const PS = (float*)(ws + WS_PS);
    bf16* const XN = (bf16*)(ws + WS_XN); bf16* const QAt = (bf16*)(ws + WS_QA); bf16* const KAt = (bf16*)(ws + WS_KA); bf16* const VAt = (bf16*)(ws + WS_VA); bf16* const QBt = (bf16*)(ws + WS_QB);
    bf16* const KBt = (bf16*)args.out; bf16* const VBt = (bf16*)((unsigned char*)args.out + 32 * MiB);
    bf16* const Gt = (bf16*)(ws + WS_G); bf16* const SAt = (bf16*)(ws + WS_SA); bf16* const SBt = (bf16*)args.out; bf16* const MGt = XN;
    const int gw = F.vcu * NWAVES + F.wave, NGW = F.G * NWAVES;

    if (IN(0)) {
        LAS float* scr = (LAS float*)(F.lds + RING_OFF + F.wave * 16384);
        constexpr int I_QKV = 16 * 192, I_G = 16 * 128, I_A = 16 * 32, I_B = 16 * 32, I_O = 16 * 32, I_MOD = 48 * 16, I_ROPE = 1024;
        constexpr int NITEMS = I_QKV + I_G + I_A + I_B + I_O + I_MOD + I_ROPE;
        for (int it = gw; it < NITEMS; it += NGW) {
            int r = it;
            if (r < I_QKV) { p0_tr_item(args.w_in, N_IN, 1024, 0, WQKV_T, 1, scr, r, 192, F.lane); continue; } r -= I_QKV;
            if (r < I_G) { p0_tr_item(args.w_in, N_IN, 1024, 0, WG_T, 2, scr, r, 128, F.lane); continue; } r -= I_G;
            if (r < I_A) { p0_tr_item(args.w_a, 1024, 2048, 0, WAB_T, 0, scr, r, 32, F.lane); continue; } r -= I_A;
            if (r < I_B) { p0_tr_item(args.w_b, 1024, 2048, 1024, WAB_T, 0, scr, r, 32, F.lane); continue; } r -= I_B;
            if (r < I_O) { p0_tr_item(args.w_out, 1024, 1024, 0, WO_T, 0, scr, r, 32, F.lane); continue; } r -= I_O;
            if (r < I_MOD) { const int chunk = r % 48, ks = r / 48, col = chunk * 64 + F.lane; float a0 = 0.f, a1 = 0.f;
#pragma unroll 8
                for (int k = ks * 64; k < ks * 64 + 64; ++k) { const float w = args.w_ada[(size_t)k * 3072 + col]; const float c0 = args.c[k], c1 = args.c[1024 + k];
                    a0 += (c0 / (1.0f + expf(-c0))) * w; a1 += (c1 / (1.0f + expf(-c1))) * w; }
                MODP[(size_t)(ks * 2 + 0) * 3072 + col] = a0; MODP[(size_t)(ks * 2 + 1) * 3072 + col] = a1; continue; } r -= I_MOD;
            {
#pragma unroll 1
                for (int j = 0; j < 8; ++j) { const int idx = r * 512 + j * 64 + F.lane, m = idx >> 5, i = idx & 31;
                    const float ang = __fmul_rn((float)args.pos[m], INV_FREQ[i]); float c, s; sincos_d(ang, c, s); COS_T[idx] = c; SIN_T[idx] = s; } }
        }
        if (BOTH(0)) GRID_BAR(0);
    }
    if (IN(1)) {
        LAS float* gs = (LAS float*)(F.lds); LAS float* sh = gs + 2048; LAS float* wf = sh + 2048;
        for (int e = F.tid; e < 2048; e += NWAVES * 64) { const int b = e >> 10, k = e & 1023; float shv = args.b_ada[k], scv = args.b_ada[1024 + k];
            for (int ks = 0; ks < 16; ++ks) { shv += MODP[(size_t)(ks * 2 + b) * 3072 + k]; scv += MODP[(size_t)(ks * 2 + b) * 3072 + 1024 + k]; }
            gs[e] = args.g_norm[k] * (1.0f + scv); sh[e] = shv;
            if (blockIdx.x == 0) { float gv = args.b_ada[2048 + k]; for (int ks = 0; ks < 16; ++ks) gv += MODP[(size_t)(ks * 2 + b) * 3072 + 2048 + k]; GATE[e] = gv; } }
        for (int e = F.tid; e < 8192; e += NWAVES * 64) { const int k = e >> 3, j = e & 7; wf[j * 1024 + k] = args.w_in[(size_t)k * N_IN + 8192 + j]; }
        __syncthreads();
        for (int m = gw; m < M; m += NGW) { const int b = m >> 13;
            const GAS f32x4* xr = (const GAS f32x4*)(args.x + (size_t)m * DM) + F.lane;
            f32x4 v[4]; float s = 0.f;
#pragma unroll
            for (int j = 0; j < 4; ++j) { v[j] = xr[64 * j]; s += (v[j].x * v[j].x + v[j].y * v[j].y) + (v[j].z * v[j].z + v[j].w * v[j].w); }
            const float rstd = 1.0f / sqrtf(wave_sum(s) * (1.0f / DM) + 1e-6f);
            float fl[8];
#pragma unroll
            for (int jj = 0; jj < 8; ++jj) fl[jj] = 0.f;
            GAS unsigned long long* o8 = (GAS unsigned long long*)(XN + (size_t)m * DM) + F.lane;
#pragma unroll
            for (int j = 0; j < 4; ++j) { const int k = 256 * j + 4 * F.lane;
                const f32x4 g4 = *(const LAS f32x4*)(gs + b * 1024 + k), s4 = *(const LAS f32x4*)(sh + b * 1024 + k);
                f32x4 h; h.x = v[j].x * rstd * g4.x + s4.x; h.y = v[j].y * rstd * g4.y + s4.y; h.z = v[j].z * rstd * g4.z + s4.z; h.w = v[j].w * rstd * g4.w + s4.w;
#pragma unroll
                for (int jj = 0; jj < 8; ++jj) { const f32x4 w4 = *(const LAS f32x4*)(wf + jj * 1024 + k); fl[jj] += (h.x * w4.x + h.y * w4.y) + (h.z * w4.z + h.w * w4.w); }
                o8[64 * j] = (unsigned long long)pk2(h.x, h.y) | ((unsigned long long)pk2(h.z, h.w) << 32); }
            float mine = 0.f;
#pragma unroll
            for (int jj = 0; jj < 8; ++jj) { const float t = wave_sum(fl[jj]); if (F.lane == jj) mine = t; }
            if (F.lane < 8) { const float z = mine + args.b_forget[F.lane]; LOGF[(size_t)m * 8 + F.lane] = fminf(z, 0.f) - log1pf(expf(-fabsf(z))); }
        }
        if (BOTH(1)) GRID_BAR(1);
    }
    if (IN(2)) {
        if (blockIdx.x < 16) { const int bh = blockIdx.x, b = bh >> 3, h = bh & 7; LAS double* wt = (LAS double*)(F.lds);
            double pre[16]; double run = 0.0;
#pragma unroll
            for (int i = 0; i < 16; ++i) { run += (double)LOGF[((size_t)b * SEQ + F.tid * 16 + i) * 8 + h]; pre[i] = run; }
            double inc = run;
#pragma unroll
            for (int o = 1; o < 64; o <<= 1) { const double t = __shfl_up(inc, o); if (F.lane >= o) inc += t; }
            if (F.lane == 63) wt[F.wave] = inc;
            __syncthreads();
            double base = inc - run;
            for (int w = 0; w < F.wave; ++w) base += wt[w];
#pragma unroll
            for (int i = 0; i < 16; ++i) CUMF[(size_t)bh * SEQ + F.tid * 16 + i] = (float)(base + pre[i]);
            __syncthreads(); }
        pg8::Gemm g{XN, WQKV_T, M, 6144, DM}; pg8::StaticOrder S; S.init(M, 6144, F.G, (int)blockIdx.x);
        pg8::EpiQKV E{QAt, KAt, VAt, QBt, KBt, VBt, COS_T, SIN_T};
        pg8::gemm_phase<pg8::EpiQKV, pg8::StaticOrder, true, true>(F.lds + RING_OFF, g, S, E);
        if (BOTH(2)) GRID_BAR(2);
    }
    if (IN(3)) {
        float s1 = 0.f, s2 = 0.f;
        for (int i = 0; i < 64; ++i) { s1 += args.lq1[i] * args.lk1[i]; s2 += args.lq2[i] * args.lk2[i]; }
        const float lam = expf(s1) - expf(s2) + 0.2f;
        const int g = blockIdx.x & 7; gu32* qctr = F.ctl + CW_Q + 64 * g; volatile LAS unsigned* qw = F.MISC + 16;
        char* albs = (char*)lds + RING_OFF;
#define PULL(dst) do { if (F.tid == 0) qw[0] = xb_add((unsigned*)qctr, 1u); __syncthreads(); dst = (int)qw[0]; __syncthreads(); } while (0)
#define REF_B(r, ix) do { const int bh_ = 2 * g + (ix) / 32, qb_ = 31 - ((ix) % 32); r.P0 = qb_ * 256; r.Q = QBt + ((size_t)bh_ * SEQ + r.P0) * HD; r.O = QBt + ((size_t)bh_ * SEQ + r.P0) * HD; \
        r.K = KBt + (size_t)bh_ * SEQ * HD; r.V = VBt + (size_t)bh_ * SEQ * HD; r.F = CUMF + (size_t)bh_ * SEQ; } while (0)
#define REF_A(r, ix) do { const int bh_ = 2 * g + (ix) / 64, qb_ = 63 - ((ix) % 64); r.P0 = qb_ * 128; r.Q = QAt + ((size_t)bh_ * SEQ + r.P0) * HD; r.O = QAt + ((size_t)bh_ * SEQ + r.P0) * HD; \
        r.K = KAt + (size_t)bh_ * SEQ * HD; r.V = VAt + (size_t)bh_ * SEQ * HD; r.F = CUMF; } while (0)
        int idx; PULL(idx);
#ifndef ATT_MASK
#define ATT_MASK 3
#endif
        if ((ATT_MASK & 2) && idx < 64) { att::BlockRef cur, nxt; REF_B(cur, idx); att::Seam S; att::attn_prime<1>(cur, albs, S);
            for (;;) { int nidx; PULL(nidx); const bool more = nidx < 64; nxt = cur; if (more) REF_B(nxt, nidx);
                att::attn_block<1>(cur, nxt, lam, args.g_subln, albs, S); idx = nidx; if (!more) break; cur = nxt; } }
        if ((ATT_MASK & 1) && idx < 192) { att::BlockRef cur, nxt; REF_A(cur, idx - 64); att::Seam S; att::attn_prime<0>(cur, albs, S);
            for (;;) { int nidx; PULL(nidx); const bool more = nidx < 192; nxt = cur; if (more) REF_A(nxt, nidx - 64);
                att::attn_block<0>(cur, nxt, lam, args.g_subln, albs, S); idx = nidx; if (!more) break; cur = nxt; } }
#undef PULL
#undef REF_A
#undef REF_B
        if (BOTH(3)) GRID_BAR(3);
    }
    if (IN(4)) {
        pg8::Gemm g{XN, WG_T, M, 4096, DM}; pg8::StaticOrder S; S.init(M, 4096, F.G, (int)blockIdx.x);
        pg8::EpiGate E{QAt, QBt, Gt, SAt, SBt};
        pg8::gemm_phase<pg8::EpiGate, pg8::StaticOrder, true, true>(F.lds + RING_OFF, g, S, E);
        if (BOTH(4)) GRID_BAR(4);
    }
    if (IN(5)) {
        pg8::Gemm g{Gt, WAB_T, M, 1024, 2048}; pg8::StaticOrder S; S.init(M, 1024, F.G, (int)blockIdx.x);
        pg8::EpiMerge E{SAt, SBt, MGt};
        pg8::gemm_phase<pg8::EpiMerge, pg8::StaticOrder, true, true>(F.lds + RING_OFF, g, S, E);
        if (BOTH(5)) GRID_BAR(5);
    }
    if (IN(6)) {
        pg8::Gemm g{MGt, WO_T, M, 1024, DM}; pg8::StaticOrder S; S.init(M, 1024, F.G, (int)blockIdx.x);
        pg8::EpiOut E{args.x, args.out, GATE, PS};
        pg8::gemm_phase<pg8::EpiOut, pg8::StaticOrder, true, true>(F.lds + RING_OFF, g, S, E);
        if (BOTH(6)) GRID_BAR(6);
    }
    if (IN(7)) {
        for (int m = gw; m < M; m += NGW) {
            float p = F.lane < 16 ? PS[(size_t)m * 16 + F.lane] : 0.f; p = wave_sum(p);
            const float rstd = 1.0f / sqrtf(p * (1.0f / DM) + 1e-6f);
            GAS f32x4* orow = (GAS f32x4*)(args.out + (size_t)m * DM) + F.lane; const GAS f32x4* gf = (const GAS f32x4*)args.g_final + F.lane;
#pragma unroll
            for (int j = 0; j < 4; ++j) { f32x4 v = orow[64 * j]; const f32x4 g4 = gf[64 * j]; v.x *= rstd * g4.x; v.y *= rstd * g4.y; v.z *= rstd * g4.z; v.w *= rstd * g4.w; orow[64 * j] = v; }
        }
    }
#undef IN
#undef BOTH
#undef GRID_BAR
}

extern "C" void kernel_launch(void* const* d_in, const int* in_sizes, int n_in, void* d_out, int out_size, void* d_ws, size_t ws_size, hipStream_t stream) {
    static int grid = 0;
    if (grid == 0) {
        if (n_in != 17 || in_sizes[0] != M * DM || out_size != M * DM || ws_size < WS_END) { fprintf(stderr, "kernel_launch: unexpected shapes (n_in %d, in0 %d, out %d, ws %zu); nothing launched\n", n_in, n_in > 0 ? in_sizes[0] : -1, out_size, ws_size); grid = -1; return; }
        int dev = 0, cus = 0;
        if (hipGetDevice(&dev) != hipSuccess || hipDeviceGetAttribute(&cus, hipDeviceAttributeMultiprocessorCount, dev) != hipSuccess) { fprintf(stderr, "kernel_launch: device query failed\n"); grid = -1; return; }
        if (hipFuncSetAttribute((const void*)fwd_kernel, hipFuncAttributeMaxDynamicSharedMemorySize, LDS_BYTES) != hipSuccess) { fprintf(stderr, "kernel_launch: hipFuncSetAttribute failed\n"); grid = -1; return; }
        int per_cu = 0;
        if (hipOccupancyMaxActiveBlocksPerMultiprocessor(&per_cu, (const void*)fwd_kernel, NWAVES * 64, LDS_BYTES) != hipSuccess || per_cu < 1)
            fprintf(stderr, "kernel_launch: note: occupancy query reports %d workgroups per CU\n", per_cu);
        (void)hipGetLastError();
        grid = cus;
    }
    if (grid < 0) return;
    if (hipMemsetAsync((char*)d_ws + WS_CTL, 0, CTL_ZERO_BYTES, stream) != hipSuccess) { fprintf(stderr, "kernel_launch: hipMemsetAsync failed\n"); return; }
    Args a{};
    a.x = (const float*)d_in[0]; a.c = (const float*)d_in[1]; a.pos = (const int*)d_in[2]; a.w_ada = (const float*)d_in[3]; a.b_ada = (const float*)d_in[4]; a.g_norm = (const float*)d_in[5];
    a.w_in = (const float*)d_in[6]; a.b_forget = (const float*)d_in[7]; a.lq1 = (const float*)d_in[8]; a.lk1 = (const float*)d_in[9]; a.lq2 = (const float*)d_in[10]; a.lk2 = (const float*)d_in[11];
    a.g_subln = (const float*)d_in[12]; a.w_a = (const float*)d_in[13]; a.w_b = (const float*)d_in[14]; a.w_out = (const float*)d_in[15]; a.g_final = (const float*)d_in[16];
    a.out = (float*)d_out; a.ws = (unsigned char*)d_ws;
    for (int li = 0; li < N_LAUNCHES; ++li) {
        a.ph_lo = (N_LAUNCHES == PER_PHASE) ? li : 0; a.ph_hi = (N_LAUNCHES == PER_PHASE) ? li + 1 : PER_PHASE; a.li = li;
        hipLaunchKernelGGL(fwd_kernel, dim3(grid), dim3(NWAVES * 64), LDS_BYTES, stream, a);
        const hipError_t le = hipPeekAtLastError();
        if (le != hipSuccess) { fprintf(stderr, "kernel_launch: launch %d failed: %s\n", li, hipGetErrorName(le)); break; }
    }
}
```

```cpp
#include <hip/hip_runtime.h>
#include <hip/hip_bf16.h>
#include <cstdio>
#include <cstdint>
#include <cmath>

constexpr int BATCH = 2, SEQ = 8192, DM = 1024, M = BATCH * SEQ, NH = 8, HD = 128, N_IN = 10248;
constexpr float LOG2E = 1.4426950408889634f;
constexpr float C2A = 0.125f * LOG2E;
constexpr float C2B = 0.08838834764831845f * LOG2E;

namespace pg8 {
#define PG8_LAS __attribute__((address_space(3)))
typedef unsigned short bf16_t;
typedef short bf16x8 __attribute__((ext_vector_type(8)));
typedef float f32x4 __attribute__((ext_vector_type(4)));
typedef unsigned u32x4 __attribute__((ext_vector_type(4)));
constexpr int BM = 256, BK = 64, HALF = 128, HTB = HALF * BK * 2  , STAGE_BYTES = 8 * HTB, NXCD = 8, WGM = 8;

__host__ __device__ __forceinline__ int lds_byte(int r, int c) { const int st = (r >> 4) * 2 + (c >> 5), rr = r & 15, cc = c & 31, ob = rr * 64 + cc * 2; return st * 1024 + (ob ^ (((ob >> 9) & 1) << 5)); }
__host__ __device__ __forceinline__ void stage_rc(int b, int& R, int& C) { const int st = b / 1024, sb = b % 1024, swz = sb ^ (((sb >> 9) & 1) << 5); R = (st >> 1) * 16 + swz / 64; C = (st & 1) * 32 + (swz % 64) / 2; }
__host__ __device__ __forceinline__ int perm32(int rho) { const int n = rho >> 4, i = rho & 15; return 8 * (i >> 2) + 4 * n + (i & 3); }

struct Unit { int pm, pn; };
struct Gemm { const bf16_t* A; const bf16_t* Bt; int M, N, K; };

struct StaticOrder {
    int nM, nN, nwg, G, c;
    __host__ __device__ void init(int M, int N, int G_, int c_) { nM = M / BM; nN = N / BM; nwg = nM * nN; G = G_; c = c_; }
    __host__ __device__ bool next(int i, Unit& u) const {
        const long L = (long)i * G + c; if (L >= nwg) return false;
        int wgid = (int)L; { const int q = nwg / NXCD, r = nwg % NXCD, xcd = wgid % NXCD, off = wgid / NXCD; wgid = (xcd < r ? xcd * (q + 1) : r * (q + 1) + (xcd - r) * q) + off; }
        const int nig = WGM * nN, gid = wgid / nig, fm = gid * WGM, gsz = (nM - fm) < WGM ? (nM - fm) : WGM;
        u.pm = fm + ((wgid % nig) % gsz); u.pn = (wgid % nig) / gsz; return true;
    }
    __device__ __forceinline__ void a_ready(const Unit&) const {}
    __device__ __forceinline__ void done(const Unit&) const {}
};
__device__ __forceinline__ unsigned cvt_pk_bf16(float lo, float hi) { unsigned r; asm volatile("v_cvt_pk_bf16_f32 %0, %1, %2" : "=v"(r) : "v"(lo), "v"(hi)); return r; }
__device__ __forceinline__ float bf_lo(unsigned w) { return __uint_as_float(w << 16); }
__device__ __forceinline__ float bf_hi(unsigned w) { return __uint_as_float(w & 0xffff0000u); }
__device__ __forceinline__ float sigm(float x) { return __builtin_amdgcn_rcpf(1.0f + __builtin_amdgcn_exp2f(-x * LOG2E)); }
__device__ __forceinline__ u32x4 pack8(const f32x4 a, const f32x4 b) { u32x4 w; w.x = cvt_pk_bf16(a[0], a[1]); w.y = cvt_pk_bf16(a[2], a[3]); w.z = cvt_pk_bf16(b[0], b[1]); w.w = cvt_pk_bf16(b[2], b[3]); return w; }

struct EpiQKV {
    static constexpr bool PERM = true, AFTER_DRAIN = false, HAS_MID = false;
    bf16_t *QA, *KA, *VA, *QB, *KB, *VB; const float* cosT; const float* sinT; float* PN;
    __device__ __forceinline__ void operator()(const f32x4 (&acc)[2][2][4][2], const Unit& u, int wr, int wc, int fr, int fq) const {
        const int type = u.pn >> 2;
        bf16_t* T = type == 0 ? QA : type == 1 ? KA : type == 2 ? VA : type == 3 ? QB : type == 4 ? KB : VB;
        const bool rope = type < 2; const float sc = type == 0 ? C2A : (type == 3 ? C2B : 1.0f);
        const int row0 = u.pm * BM + wr * 64 + fr, b = (u.pm * BM) >> 13, d = wc * 32 + 8 * fq, i0 = (wc & 1) * 16 + 4 * fq;
#pragma unroll
        for (int ai = 0; ai < 2; ++ai)
#pragma unroll
            for (int m = 0; m < 4; ++m) { const int row = row0 + ai * HALF + m * 16, s = row & (SEQ - 1);
                f32x4 c4 = {1.f, 1.f, 1.f, 1.f}, s4 = {0.f, 0.f, 0.f, 0.f};
                if (rope) { c4 = *(const f32x4*)(cosT + (size_t)row * 32 + i0); s4 = *(const f32x4*)(sinT + (size_t)row * 32 + i0); }
#pragma unroll
                for (int bj = 0; bj < 2; ++bj) { const int h = (u.pn & 3) * 2 + bj;
                    f32x4 v0 = acc[ai][bj][m][0], v1 = acc[ai][bj][m][1];
                    if (rope) { f32x4 r0, r1;
                        r0[0] = v0[0] * c4[0] - v0[1] * s4[0]; r0[1] = v0[0] * s4[0] + v0[1] * c4[0];
                        r0[2] = v0[2] * c4[1] - v0[3] * s4[1]; r0[3] = v0[2] * s4[1] + v0[3] * c4[1];
                        r1[0] = v1[0] * c4[2] - v1[1] * s4[2]; r1[1] = v1[0] * s4[2] + v1[1] * c4[2];
                        r1[2] = v1[2] * c4[3] - v1[3] * s4[3]; r1[3] = v1[2] * s4[3] + v1[3] * c4[3];
                        v0 = r0; v1 = r1; }
                    v0 = v0 * sc; v1 = v1 * sc;
                    if (type == 3 || type == 4) { float ss = (v0[0] * v0[0] + v0[1] * v0[1]) + (v0[2] * v0[2] + v0[3] * v0[3]) + (v1[0] * v1[0] + v1[1] * v1[1]) + (v1[2] * v1[2] + v1[3] * v1[3]);
                        ss += __shfl_xor(ss, 16); ss += __shfl_xor(ss, 32);
                        if (fq == 0) PN[((size_t)(type - 3) * 16 * SEQ + (size_t)(b * NH + h) * SEQ + s) * 4 + wc] = ss; }
                    *(u32x4*)(T + ((size_t)((b * NH + h) * SEQ + s)) * HD + d) = pack8(v0, v1); }
                if (m & 1) asm volatile("" ::: "memory"); }
    }
};
struct EpiGate {
    static constexpr bool PERM = true, AFTER_DRAIN = false, HAS_MID = false;
    const bf16_t *OA, *OB; bf16_t *G, *SA, *SB;
    __device__ __forceinline__ void operator()(const f32x4 (&acc)[2][2][4][2], const Unit& u, int wr, int wc, int fr, int fq) const {
        const int type = u.pn >> 2;
        const int row0 = u.pm * BM + wr * 64 + fr, b = (u.pm * BM) >> 13, d = wc * 32 + 8 * fq, n0 = (u.pn & 3) * 256 + d;
#pragma unroll
        for (int ai = 0; ai < 2; ++ai)
#pragma unroll
            for (int m = 0; m < 4; ++m) { const int row = row0 + ai * HALF + m * 16, s = row & (SEQ - 1);
#pragma unroll
                for (int bj = 0; bj < 2; ++bj) { const int h = (u.pn & 3) * 2 + bj, n = n0 + bj * HALF;
                    f32x4 v0 = acc[ai][bj][m][0], v1 = acc[ai][bj][m][1];
#pragma unroll
                    for (int j = 0; j < 4; ++j) { v0[j] = sigm(v0[j]); v1[j] = sigm(v1[j]); }
                    if (type < 2) { const bf16_t* O = type == 0 ? OA : OB;
                        const u32x4 ow = *(const u32x4*)(O + ((size_t)((b * NH + h) * SEQ + s)) * HD + d);
                        const f32x4 z0 = acc[ai][bj][m][0], z1 = acc[ai][bj][m][1];
                        v0[0] *= z0[0] * bf_lo(ow.x); v0[1] *= z0[1] * bf_hi(ow.x); v0[2] *= z0[2] * bf_lo(ow.y); v0[3] *= z0[3] * bf_hi(ow.y);
                        v1[0] *= z1[0] * bf_lo(ow.z); v1[1] *= z1[1] * bf_hi(ow.z); v1[2] *= z1[2] * bf_lo(ow.w); v1[3] *= z1[3] * bf_hi(ow.w);
                        *(u32x4*)(G + (size_t)row * 2048 + type * 1024 + n) = pack8(v0, v1); }
                    else { bf16_t* S_ = type == 2 ? SA : SB; *(u32x4*)(S_ + (size_t)row * 1024 + n) = pack8(v0, v1); } }
                asm volatile("" ::: "memory"); }
    }
};
struct EpiMerge {
    static constexpr bool PERM = true, AFTER_DRAIN = false, HAS_MID = true;
    const bf16_t *SA, *SB; bf16_t* MG;
    __device__ __forceinline__ void mid(f32x4 (&acc)[2][2][4][2], const Unit& u, int wr, int wc, int fr, int fq) const {
        int opq = 0; asm volatile("" : "+v"(opq));
        const int row0 = u.pm * BM + wr * 64 + fr + opq, c0 = u.pn * BM + wc * 32 + 8 * fq;
#pragma unroll
        for (int ai = 0; ai < 2; ++ai)
#pragma unroll
            for (int m = 0; m < 4; ++m) { const size_t ro = (size_t)(row0 + ai * HALF + m * 16) * 1024 + c0;
#pragma unroll
                for (int bj = 0; bj < 2; ++bj) { const u32x4 a = *(const u32x4*)(SA + ro + bj * HALF), bb = *(const u32x4*)(SB + ro + bj * HALF);
                    const float TINY = 8.6736174e-19f;
                    f32x4 r0, r1;
                    r0[0] = bf_lo(a.x) * __builtin_amdgcn_rcpf(fmaxf(bf_lo(bb.x), TINY)); r0[1] = bf_hi(a.x) * __builtin_amdgcn_rcpf(fmaxf(bf_hi(bb.x), TINY));
                    r0[2] = bf_lo(a.y) * __builtin_amdgcn_rcpf(fmaxf(bf_lo(bb.y), TINY)); r0[3] = bf_hi(a.y) * __builtin_amdgcn_rcpf(fmaxf(bf_hi(bb.y), TINY));
                    r1[0] = bf_lo(a.z) * __builtin_amdgcn_rcpf(fmaxf(bf_lo(bb.z), TINY)); r1[1] = bf_hi(a.z) * __builtin_amdgcn_rcpf(fmaxf(bf_hi(bb.z), TINY));
                    r1[2] = bf_lo(a.w) * __builtin_amdgcn_rcpf(fmaxf(bf_lo(bb.w), TINY)); r1[3] = bf_hi(a.w) * __builtin_amdgcn_rcpf(fmaxf(bf_hi(bb.w), TINY));
                    acc[ai][bj][m][0] = acc[ai][bj][m][0] * r0; acc[ai][bj][m][1] = acc[ai][bj][m][1] * r1; }
                asm volatile("" ::: "memory"); }
    }
    __device__ __forceinline__ void operator()(const f32x4 (&acc)[2][2][4][2], const Unit& u, int wr, int wc, int fr, int fq) const {
        const int row0 = u.pm * BM + wr * 64 + fr, c0 = u.pn * BM + wc * 32 + 8 * fq;
#pragma unroll
        for (int ai = 0; ai < 2; ++ai)
#pragma unroll
            for (int m = 0; m < 4; ++m) { const size_t ro = (size_t)(row0 + ai * HALF + m * 16) * 1024 + c0;
#pragma unroll
                for (int bj = 0; bj < 2; ++bj) { const u32x4 bb = *(const u32x4*)(SB + ro + bj * HALF);
                    const float TINY = 8.6736174e-19f;
                    f32x4 s0, s1;
                    s0[0] = fmaxf(bf_lo(bb.x), TINY); s0[1] = fmaxf(bf_hi(bb.x), TINY); s0[2] = fmaxf(bf_lo(bb.y), TINY); s0[3] = fmaxf(bf_hi(bb.y), TINY);
                    s1[0] = fmaxf(bf_lo(bb.z), TINY); s1[1] = fmaxf(bf_hi(bb.z), TINY); s1[2] = fmaxf(bf_lo(bb.w), TINY); s1[3] = fmaxf(bf_hi(bb.w), TINY);
                    *(u32x4*)(MG + ro + bj * HALF) = pack8(acc[ai][bj][m][0] * s0, acc[ai][bj][m][1] * s1); }
                asm volatile("" ::: "memory"); }
    }
};
struct EpiOut {
    static constexpr bool PERM = false, AFTER_DRAIN = false, HAS_MID = false;
    const float* x; float* out; const float* gate; float* PS;
    __device__ __forceinline__ void operator()(const f32x4 (&acc)[2][2][4][2], const Unit& u, int wr, int wc, int fr, int fq) const {
        const int row0 = u.pm * BM + wr * 64 + fr, b = (u.pm * BM) >> 13, col0 = u.pn * BM + wc * 32 + 4 * fq;
        f32x4 gv[2][2];
#pragma unroll
        for (int bj = 0; bj < 2; ++bj)
#pragma unroll
            for (int n = 0; n < 2; ++n) gv[bj][n] = *(const f32x4*)(gate + b * 1024 + col0 + bj * HALF + n * 16);
#pragma unroll
        for (int ai = 0; ai < 2; ++ai)
#pragma unroll
            for (int m = 0; m < 4; ++m) { const int row = row0 + ai * HALF + m * 16; const size_t ro = (size_t)row * 1024 + col0; float ss = 0.f;
#pragma unroll
                for (int bj = 0; bj < 2; ++bj)
#pragma unroll
                    for (int n = 0; n < 2; ++n) { const f32x4 xv = *(const f32x4*)(x + ro + bj * HALF + n * 16); const f32x4 o = xv + gv[bj][n] * acc[ai][bj][m][n];
                        ss += (o[0] * o[0] + o[1] * o[1]) + (o[2] * o[2] + o[3] * o[3]); *(f32x4*)(out + ro + bj * HALF + n * 16) = o; }
                ss += __shfl_xor(ss, 16); ss += __shfl_xor(ss, 32);
                if (fq == 0) PS[(size_t)row * 16 + u.pn * 4 + wc] = ss;
                if (m & 1) asm volatile("" ::: "memory"); }
    }
};

template <class Epi, class Sched, bool ALIGN_EPI = false, bool SP2 = false>
__device__ __forceinline__ void gemm_phase(PG8_LAS unsigned char* lds, const Gemm g, const Sched& S, const Epi& E) {
    const int tid = threadIdx.x, wid = __builtin_amdgcn_readfirstlane(tid >> 6), lane = tid & 63, wr = wid >> 2, wc = wid & 3, fr = lane & 15, fq = lane >> 4;
    const int K = g.K, nt = K / BK;
    unsigned voffA[2], voffB[2];
#pragma unroll
    for (int i = 0; i < 2; ++i) { int R, C; stage_rc(tid * 16 + i * 8192, R, C); const int Rb = Epi::PERM ? ((R & ~31) + perm32(R & 31)) : R;
        voffA[i] = (unsigned)(R * K + C) * 2u; voffB[i] = (unsigned)(Rb * K + C) * 2u; }
    const size_t kstep = (size_t)(BK * 2);
    const size_t hstep = (size_t)HALF * K * 2;
    const size_t tstep = 2 * hstep;
    const unsigned ldsw = (unsigned)wid * 1024u;
    const int aoff = lds_byte(wr * 64 + fr, fq * 8), boff = lds_byte(wc * 32 + fr, fq * 8);
#define PG8_SA(b, h) (((b) * 2 + (h)) * HTB)
#define PG8_SB(b, h) ((4 + (b) * 2 + (h)) * HTB)
#define PG8_STAGE(bufoff, gbase, voff) do { _Pragma("unroll") for (int _i = 0; _i < 2; ++_i) \
        __builtin_amdgcn_global_load_lds((const unsigned*)((const char*)(gbase) + (voff)[_i]), (PG8_LAS unsigned*)(lds + (bufoff) + ldsw + _i * 8192), 16, 0, 0); } while (0)
#define PG8_LDA(dst, b, h) do { _Pragma("unroll") for (int m = 0; m < 4; ++m) _Pragma("unroll") for (int k = 0; k < 2; ++k) dst[m][k] = *(const PG8_LAS bf16x8*)(lds + PG8_SA(b, h) + aoff + m * 2048 + k * 1024); } while (0)
#define PG8_LDB(dst, b, h) do { _Pragma("unroll") for (int n = 0; n < 2; ++n) _Pragma("unroll") for (int k = 0; k < 2; ++k) dst[n][k] = *(const PG8_LAS bf16x8*)(lds + PG8_SB(b, h) + boff + n * 2048 + k * 1024); } while (0)
#define PG8_MMA(ai, bj, At, Bt) do { __builtin_amdgcn_s_setprio(1); _Pragma("unroll") for (int m = 0; m < 4; ++m) _Pragma("unroll") for (int n = 0; n < 2; ++n) _Pragma("unroll") for (int k = 0; k < 2; ++k) \
        acc[ai][bj][m][n] = __builtin_amdgcn_mfma_f32_16x16x32_bf16(Bt[n][k], At[m][k], acc[ai][bj][m][n], 0, 0, 0); __builtin_amdgcn_s_setprio(0); } while (0)
#define PG8_WAIT_V(n) asm volatile("s_waitcnt vmcnt(" #n ")" ::: "memory")
#define PG8_WAIT_L(n) asm volatile("s_waitcnt lgkmcnt(" #n ")" ::: "memory")
#define PG8_BAR __builtin_amdgcn_s_barrier()
#define PG8_SCHED __builtin_amdgcn_sched_barrier(0)
    Unit cur, nxt; int ui = 0;
    if (!S.next(0, cur)) return;
    f32x4 acc[2][2][4][2];
#pragma unroll
    for (int a = 0; a < 2; ++a)
#pragma unroll
        for (int b = 0; b < 2; ++b)
#pragma unroll
            for (int m = 0; m < 4; ++m)
#pragma unroll
                for (int n = 0; n < 2; ++n) acc[a][b][m][n] = (f32x4){0.f, 0.f, 0.f, 0.f};
    bf16x8 At[4][2], B0[2][2], B1[2][2];
    const char* cA = (const char*)g.A + (size_t)cur.pm * tstep; const char* cB = (const char*)g.Bt + (size_t)cur.pn * tstep;
    S.a_ready(cur);
    if constexpr (SP2) {
        PG8_STAGE(PG8_SB(0, 0), cB, voffB); PG8_STAGE(PG8_SB(0, 1), cB + hstep, voffB); PG8_STAGE(PG8_SA(0, 0), cA, voffA); PG8_STAGE(PG8_SA(0, 1), cA + hstep, voffA);
        if (wr == 1) PG8_BAR;
        PG8_WAIT_V(2); PG8_BAR;
        PG8_STAGE(PG8_SB(1, 0), cB + kstep, voffB); PG8_STAGE(PG8_SA(1, 0), cA + kstep, voffA); PG8_STAGE(PG8_SB(1, 1), cB + hstep + kstep, voffB);
        PG8_WAIT_V(6); PG8_BAR;
    } else {
        PG8_STAGE(PG8_SB(0, 0), cB, voffB); PG8_STAGE(PG8_SA(0, 0), cA, voffA); PG8_STAGE(PG8_SB(0, 1), cB + hstep, voffB); PG8_STAGE(PG8_SA(0, 1), cA + hstep, voffA);
        if (wr == 1) PG8_BAR;
        PG8_WAIT_V(4); PG8_BAR;
        PG8_STAGE(PG8_SB(1, 0), cB + kstep, voffB); PG8_STAGE(PG8_SA(1, 0), cA + kstep, voffA); PG8_STAGE(PG8_SB(1, 1), cB + hstep + kstep, voffB);
        PG8_WAIT_V(6); PG8_BAR;
    }
    for (;;) {
        const bool has_next = S.next(ui + 1, nxt);
        const char* nA = has_next ? (const char*)g.A + (size_t)nxt.pm * tstep : cA; const char* nB = has_next ? (const char*)g.Bt + (size_t)nxt.pn * tstep : cB;
        for (int t = 0; t < nt; t += 2) {
            const bool last = (t == nt - 2);
            const char* a1 = cA + (size_t)(t + 1) * kstep;
            const char* a2 = last ? nA : cA + (size_t)(t + 2) * kstep; const char* b2 = last ? nB : cB + (size_t)(t + 2) * kstep;
            const char* a3 = a2 + kstep; const char* b3 = b2 + kstep;
            if (last && has_next) S.a_ready(nxt);
            if constexpr (SP2) {
            PG8_LDB(B0, 0, 0); PG8_LDB(B1, 0, 1); PG8_SCHED; PG8_LDA(At, 0, 0); PG8_STAGE(PG8_SA(1, 1), a1 + hstep, voffA);
            PG8_WAIT_V(8); PG8_WAIT_L(0); PG8_BAR; PG8_MMA(0, 0, At, B0); PG8_MMA(0, 1, At, B1); PG8_BAR; PG8_SCHED;
            PG8_LDA(At, 0, 1); PG8_STAGE(PG8_SB(0, 0), b2, voffB); PG8_STAGE(PG8_SB(0, 1), b2 + hstep, voffB); PG8_STAGE(PG8_SA(0, 0), a2, voffA);
            PG8_WAIT_V(8); PG8_WAIT_L(0); PG8_BAR; PG8_MMA(1, 0, At, B0); PG8_MMA(1, 1, At, B1); PG8_BAR; PG8_SCHED;
            PG8_LDB(B0, 1, 0); PG8_LDB(B1, 1, 1); PG8_SCHED; PG8_LDA(At, 1, 0); PG8_STAGE(PG8_SA(0, 1), a2 + hstep, voffA);
            PG8_WAIT_V(8); PG8_WAIT_L(0); PG8_BAR; PG8_MMA(0, 0, At, B0); PG8_MMA(0, 1, At, B1); PG8_BAR; PG8_SCHED;
            PG8_LDA(At, 1, 1); PG8_STAGE(PG8_SB(1, 0), b3, voffB); PG8_STAGE(PG8_SB(1, 1), b3 + hstep, voffB); PG8_STAGE(PG8_SA(1, 0), a3, voffA);
            PG8_WAIT_V(8); PG8_WAIT_L(0); PG8_BAR; PG8_MMA(1, 0, At, B0); PG8_MMA(1, 1, At, B1); PG8_BAR; PG8_SCHED;
            } else {
            PG8_LDB(B0, 0, 0); PG8_SCHED; PG8_LDA(At, 0, 0); PG8_STAGE(PG8_SA(1, 1), a1 + hstep, voffA);
            PG8_WAIT_L(8); PG8_BAR; PG8_WAIT_L(0); PG8_MMA(0, 0, At, B0); PG8_BAR; PG8_SCHED;
            PG8_LDB(B1, 0, 1); PG8_STAGE(PG8_SB(0, 0), b2, voffB);
            PG8_BAR; PG8_WAIT_L(0); PG8_MMA(0, 1, At, B1); PG8_BAR;
            PG8_LDA(At, 0, 1); PG8_STAGE(PG8_SA(0, 0), a2, voffA);
            PG8_BAR; PG8_WAIT_L(0); PG8_MMA(1, 0, At, B0); PG8_BAR; PG8_SCHED;
            PG8_STAGE(PG8_SB(0, 1), b2 + hstep, voffB);
            PG8_WAIT_V(6); PG8_BAR; PG8_MMA(1, 1, At, B1); PG8_BAR;
            PG8_LDB(B0, 1, 0); PG8_SCHED; PG8_LDA(At, 1, 0); PG8_STAGE(PG8_SA(0, 1), a2 + hstep, voffA);
            PG8_WAIT_L(8); PG8_BAR; PG8_WAIT_L(0); PG8_MMA(0, 0, At, B0); PG8_BAR; PG8_SCHED;
            PG8_LDB(B1, 1, 1); PG8_STAGE(PG8_SB(1, 0), b3, voffB);
            PG8_BAR; PG8_WAIT_L(0); PG8_MMA(0, 1, At, B1); PG8_BAR;
            PG8_LDA(At, 1, 1); PG8_STAGE(PG8_SA(1, 0), a3, voffA);
            PG8_BAR; PG8_WAIT_L(0); PG8_MMA(1, 0, At, B0); PG8_BAR; PG8_SCHED;
            PG8_STAGE(PG8_SB(1, 1), b3 + hstep, voffB);
            PG8_WAIT_V(6); PG8_BAR; PG8_MMA(1, 1, At, B1); PG8_BAR;
            }
            if constexpr (Epi::HAS_MID) { if (t + 2 == (nt >> 1)) E.mid(acc, cur, wr, wc, fr, fq); }
        }
        if constexpr (ALIGN_EPI) { if (wr == 0) PG8_BAR; }
        if constexpr (!Epi::AFTER_DRAIN) { E(acc, cur, wr, wc, fr, fq); S.done(cur); }
        if (!has_next) break;
#pragma unroll
        for (int a = 0; a < 2; ++a)
#pragma unroll
            for (int b = 0; b < 2; ++b)
#pragma unroll
                for (int m = 0; m < 4; ++m)
#pragma unroll
                    for (int n = 0; n < 2; ++n) acc[a][b][m][n] = (f32x4){0.f, 0.f, 0.f, 0.f};
        cur = nxt; cA = nA; cB = nB; ++ui;
        if constexpr (ALIGN_EPI) { if (wr == 1) PG8_BAR; }
    }
    PG8_WAIT_V(0);
    if constexpr (!ALIGN_EPI) { if (wr == 0) PG8_BAR; }
    PG8_BAR;
    if constexpr (Epi::AFTER_DRAIN) { E.fused(acc, cur, wr, wc, fr, fq, lds, wid, lane); S.done(cur); }
#undef PG8_SA
#undef PG8_SB
#undef PG8_STAGE
#undef PG8_LDA
#undef PG8_LDB
#undef PG8_MMA
#undef PG8_WAIT_V
#undef PG8_WAIT_L
#undef PG8_BAR
#undef PG8_SCHED
}
}

namespace att {
using bf16 = unsigned short;
typedef short bf16x8 __attribute__((ext_vector_type(8)));
typedef short s16x4 __attribute__((ext_vector_type(4)));
typedef float f32x16 __attribute__((ext_vector_type(16)));
typedef float f32x4 __attribute__((ext_vector_type(4)));
typedef unsigned u32x4 __attribute__((ext_vector_type(4)));
constexpr int D = 128, KVBLK = 64, SHM_V = KVBLK * D * 2, SHM_K = KVBLK * D * 2;
constexpr int OFF_V = 0, OFF_K = 2 * SHM_V, OFF_WS = OFF_K + 2 * SHM_K, OFF_FL = OFF_WS + 8 * 64 * 4, OFF_XCH = OFF_FL + 2 * 64 * 4, LDS_NEED = OFF_XCH + 4 * 64 * 64 * 4;
constexpr float THR2 = 8.0f * LOG2E;
#define KSWZ(row, colB) ((row) * 256 + ((colB) ^ (((row) & 7) << 4)))
#define SBAR() __builtin_amdgcn_sched_barrier(0)
__device__ __forceinline__ int v_st(int k, int c) { const int kk = (k & ~0xC) | ((k & 4) << 1) | ((k & 8) >> 1); return ((kk >> 3) * 4 + (c >> 5)) * 512 + ((kk & 7) * 32 + (c & 31)) * 2; }
__device__ __forceinline__ int v_rd_base(int lane) { return ((lane & 3) << 3) | (((lane >> 2) & 3) << 6) | (((lane >> 4) & 1) << 5) | (((lane >> 5) & 1) << 8); }
constexpr int v_rd_off(int d0, int ks, int half) { return d0 * 512 + ks * 4096 + half * 2048; }
__device__ __forceinline__ int crow(int r, int hi) { return (r & 3) + 8 * (r >> 2) + 4 * hi; }
__device__ __forceinline__ unsigned cvtpk(float lo, float hi) { unsigned r; asm volatile("v_cvt_pk_bf16_f32 %0, %1, %2" : "=v"(r) : "v"(lo), "v"(hi)); return r; }
__device__ __forceinline__ bf16x8 load8(const bf16* p) { return *reinterpret_cast<const bf16x8*>(p); }
__device__ __forceinline__ void mask_tile(f32x16& p0, f32x16& p1, int dq) {
    const float NEG = -__builtin_inff();
#pragma unroll
    for (int r = 0; r < 16; ++r) { const int c = (r & 3) + 8 * (r >> 2); if (dq - c < 0) p0[r] = NEG; if (dq - c - 32 < 0) p1[r] = NEG; }
}
__device__ __forceinline__ void partialSM(f32x16& p0, f32x16& p1, float& m_reg, float& mn, float& alpha) {
    float pmax = p0[0];
#pragma unroll
    for (int r = 1; r < 16; ++r) pmax = fmaxf(pmax, p0[r]);
#pragma unroll
    for (int r = 0; r < 16; ++r) pmax = fmaxf(pmax, p1[r]);
    { auto rr = __builtin_amdgcn_permlane32_swap(__float_as_uint(pmax), __float_as_uint(pmax), false, false);
      pmax = fmaxf(__uint_as_float(rr[0]), __uint_as_float(rr[1])); }
    if (__builtin_expect(__all((pmax - m_reg) <= THR2), 1)) { mn = m_reg; alpha = 1.f; }
    else { mn = fmaxf(m_reg, pmax); alpha = __builtin_amdgcn_exp2f(m_reg - mn); m_reg = mn; }
#pragma unroll
    for (int r = 0; r < 16; ++r) p0[r] = p0[r] - mn;
#pragma unroll
    for (int r = 0; r < 16; ++r) p1[r] = p1[r] - mn;
#pragma unroll
    for (int r = 0; r < 16; ++r) p0[r] = __builtin_amdgcn_exp2f(p0[r]);
}
__device__ __forceinline__ void finishSM(f32x16& p0, f32x16& p1, float alpha, float& l_reg, bf16x8& pa0, bf16x8& pa1, bf16x8& pa2, bf16x8& pa3) {
#pragma unroll
    for (int r = 0; r < 16; ++r) p1[r] = __builtin_amdgcn_exp2f(p1[r]);
    float ps = 0;
#pragma unroll
    for (int r = 0; r < 16; ++r) ps += p0[r];
#pragma unroll
    for (int r = 0; r < 16; ++r) ps += p1[r];
    { auto rr = __builtin_amdgcn_permlane32_swap(__float_as_uint(ps), __float_as_uint(ps), false, false);
      ps = __uint_as_float(rr[0]) + __uint_as_float(rr[1]); }
    l_reg = l_reg * alpha + ps;
#define PK4(P, B_, OUT) do { unsigned a0 = cvtpk(P[B_+0], P[B_+1]), a1 = cvtpk(P[B_+2], P[B_+3]);                          \
        unsigned b0 = cvtpk(P[B_+4], P[B_+5]), b1 = cvtpk(P[B_+6], P[B_+7]);                                             \
        auto r0 = __builtin_amdgcn_permlane32_swap(a0, b0, false, false); auto r1 = __builtin_amdgcn_permlane32_swap(a1, b1, false, false); \
        u32x4 w = {r0[0], r1[0], r0[1], r1[1]}; OUT = *reinterpret_cast<bf16x8*>(&w); } while (0)
    PK4(p0, 0, pa0); PK4(p0, 8, pa1); PK4(p1, 0, pa2); PK4(p1, 8, pa3);
#undef PK4
}
template <int KB, int MODE>
__device__ __forceinline__ void qkt(f32x16& p0, f32x16& p1, const char* K_lds, const float* Fl, int r32, int hi, const bf16x8* qr, const char* ql, bool act, int khalf) {
    if (!act) { const float NEG = -__builtin_inff();
#pragma unroll
        for (int r = 0; r < 16; ++r) { p0[r] = NEG; p1[r] = NEG; } return; }
    if constexpr (MODE == 1) { const float* gb = Fl + KB * 64 + 4 * hi;
#pragma unroll
        for (int g = 0; g < 4; ++g) { const f32x4 a = *(const f32x4*)(gb + 8 * g), b = *(const f32x4*)(gb + 32 + 8 * g);
            p0[4 * g] = a[0]; p0[4 * g + 1] = a[1]; p0[4 * g + 2] = a[2]; p0[4 * g + 3] = a[3];
            p1[4 * g] = b[0]; p1[4 * g + 1] = b[1]; p1[4 * g + 2] = b[2]; p1[4 * g + 3] = b[3]; } }
    else { p0 = f32x16{}; p1 = f32x16{}; }
    const char* kb[4];
#pragma unroll
    for (int dd = 0; dd < 4; ++dd) kb[dd] = K_lds + KB * SHM_K + KSWZ(r32, (dd * 16 + hi * 8) * 2);
    if constexpr (MODE == 1) {
#pragma unroll
        for (int d0 = 0; d0 < 8; ++d0) { const char* a = kb[d0 & 3] + (d0 >> 2) * 128;
            bf16x8 b0 = *reinterpret_cast<const bf16x8*>(a);
            bf16x8 b1 = *reinterpret_cast<const bf16x8*>(a + 32 * 256);
            const bf16x8 q = *reinterpret_cast<const bf16x8*>(ql + d0 * 1024);
            p0 = __builtin_amdgcn_mfma_f32_32x32x16_bf16(b0, q, p0, 0, 0, 0);
            p1 = __builtin_amdgcn_mfma_f32_32x32x16_bf16(b1, q, p1, 0, 0, 0); }
    } else {
#pragma unroll
        for (int d0 = 0; d0 < 4; ++d0) { const char* a = kb[d0] + khalf * 128;
            bf16x8 b0 = *reinterpret_cast<const bf16x8*>(a);
            bf16x8 b1 = *reinterpret_cast<const bf16x8*>(a + 32 * 256);
            p0 = __builtin_amdgcn_mfma_f32_32x32x16_bf16(b0, qr[d0], p0, 0, 0, 0);
            p1 = __builtin_amdgcn_mfma_f32_32x32x16_bf16(b1, qr[d0], p1, 0, 0, 0); }
    }
}
template <int VB>
__device__ __forceinline__ void pv_tile(f32x16* o, int vb0, bf16x8 pa0, bf16x8 pa1, bf16x8 pa2, bf16x8 pa3, bool act) {
    if (!act) return;
#define TRRD(dst, off) asm volatile("ds_read_b64_tr_b16 %0, %1 offset:%2" : "=&v"(dst) : "v"(vb0), "i"(off) : "memory")
#define PV_D0(d0) do { s16x4 l0, l1, l2, l3, h0, h1, h2, h3; constexpr int b_ = OFF_V + VB * SHM_V + v_rd_off(d0, 0, 0);   \
        TRRD(l0, b_); TRRD(h0, b_ + 2048); TRRD(l1, b_ + 4096); TRRD(h1, b_ + 6144); TRRD(l2, b_ + 8192); TRRD(h2, b_ + 10240); TRRD(l3, b_ + 12288); TRRD(h3, b_ + 14336); \
        asm volatile("s_waitcnt lgkmcnt(0)" ::: "memory"); SBAR();   \
        o[d0] = __builtin_amdgcn_mfma_f32_32x32x16_bf16(pa0, (bf16x8){l0[0], l0[1], l0[2], l0[3], h0[0], h0[1], h0[2], h0[3]}, o[d0], 0, 0, 0);   \
        o[d0] = __builtin_amdgcn_mfma_f32_32x32x16_bf16(pa1, (bf16x8){l1[0], l1[1], l1[2], l1[3], h1[0], h1[1], h1[2], h1[3]}, o[d0], 0, 0, 0);   \
        o[d0] = __builtin_amdgcn_mfma_f32_32x32x16_bf16(pa2, (bf16x8){l2[0], l2[1], l2[2], l2[3], h2[0], h2[1], h2[2], h2[3]}, o[d0], 0, 0, 0);   \
        o[d0] = __builtin_amdgcn_mfma_f32_32x32x16_bf16(pa3, (bf16x8){l3[0], l3[1], l3[2], l3[3], h3[0], h3[1], h3[2], h3[3]}, o[d0], 0, 0, 0); } while (0)
    PV_D0(0); PV_D0(1); PV_D0(2); PV_D0(3);
#undef PV_D0
#undef TRRD
}
struct BlockRef { const bf16* Q; const bf16* K; const bf16* V; bf16* O; const float* F; int P0; };
struct Seam { bf16x8 qr[8]; bf16x8 st_v0, st_v1, st_k0, st_k1; float st_f; };
__device__ __forceinline__ float ld_agent(const float* p) { return __uint_as_float((unsigned)__builtin_amdgcn_readfirstlane((int)__float_as_uint(__hip_atomic_load(p, __ATOMIC_RELAXED, __HIP_MEMORY_SCOPE_AGENT)))); }
__device__ __forceinline__ int fox_nt(const float* F, int P0, float bnd_nat) {
    const int lane = threadIdx.x & 63, jl = (P0 + 255) >> 6;
    const float thresh = ld_agent(F + P0) + bnd_nat;
    int n = 0;
    for (int base = 0; base <= jl; base += 64) {
        const int j = jl - base - lane; bool need = false;
        if (j >= 0) need = __hip_atomic_load(F + 64 * j + 63, __ATOMIC_RELAXED, __HIP_MEMORY_SCOPE_AGENT) <= thresh;
        const int c = __popcll(__ballot(need)); n += c; if (c < 64) break;
    }
    n = n < 4 ? 4 : n; n = n > jl + 1 ? jl + 1 : n;
    return __builtin_amdgcn_readfirstlane(n);
}
#define ROW(p, k0, rr) ((p) + (size_t)((k0) + (rr)) * D + sc)
#define VMW() asm volatile("s_waitcnt vmcnt(0)" ::: "memory")
#define VMWN(n) asm volatile("s_waitcnt vmcnt(%0)" :: "i"(n) : "memory")
#define SLOADX(Kp, Vp, Fp, k0) do { S.st_v0 = load8(ROW(Vp, k0, sr)); S.st_v1 = load8(ROW(Vp, k0, 32 + sr));              \
                         S.st_k0 = load8(ROW(Kp, k0, sr)); S.st_k1 = load8(ROW(Kp, k0, 32 + sr));                          \
                         if (MODE == 1 && wid == 0) S.st_f = (Fp)[(k0) + lane]; } while (0)
#define SWRITE_HK(bf, fr_) do { *(bf16x8*)(K_lds + (bf) * SHM_K + kws) = S.st_k0; *(bf16x8*)(K_lds + (bf) * SHM_K + kws + 32 * 256) = S.st_k1; \
                         if (MODE == 1 && wid == 0) Fl[(bf) * 64 + lane] = ((fr_) - S.st_f) * LOG2E; } while (0)
#define SWRITE_HV(bf) do { *(bf16x8*)(V_lds + (bf) * SHM_V + vst0) = S.st_v0; *(bf16x8*)(V_lds + (bf) * SHM_V + vst1) = S.st_v1; } while (0)
template <int MODE>
__device__ __forceinline__ void attn_prime(const BlockRef& cur, char* lds, Seam& S) {
    constexpr int QROWS = MODE == 0 ? 128 : 256;
    const int tid = threadIdx.x, wid = __builtin_amdgcn_readfirstlane(tid >> 6), lane = tid & 63, r32 = lane & 31, hi = lane >> 5;
    const int sr = tid >> 4, sc = (tid & 15) * 8, kws = KSWZ(sr, sc * 2); char* K_lds = lds + OFF_K; float* Fl = (float*)(lds + OFF_FL);
    const int kb0 = ((cur.P0 + QROWS - 1) / KVBLK) * KVBLK;
    if constexpr (MODE == 0) {
#pragma unroll
        for (int d0 = 0; d0 < 4; ++d0) S.qr[d0] = load8(cur.Q + (size_t)((wid & 3) * 32 + r32) * D + (wid >> 2) * 64 + d0 * 16 + hi * 8);
    } else {
#pragma unroll
        for (int d0 = 0; d0 < 8; ++d0) S.qr[d0] = load8(cur.Q + (size_t)(wid * 32 + r32) * D + d0 * 16 + hi * 8);
    }
    float fref = 0.f; if constexpr (MODE == 1) fref = ld_agent(cur.F + cur.P0);
    SLOADX(cur.K, cur.V, cur.F, kb0); VMW(); SWRITE_HK(0, fref);
    __syncthreads();
}
template <int MODE>
__device__ __forceinline__ void attn_block(const BlockRef& cur, const BlockRef& nxt, const int NT, float lam, const float* gsub, char* lds, Seam& S) {
    constexpr int QROWS = MODE == 0 ? 128 : 256, NQL = MODE == 0 ? 4 : 8;
    const int tid = threadIdx.x, wid = __builtin_amdgcn_readfirstlane(tid >> 6), lane = tid & 63, r32 = lane & 31, hi = lane >> 5;
    const int jl = (cur.P0 + QROWS - 1) / KVBLK;
    const int kbn = ((nxt.P0 + QROWS - 1) / KVBLK) * KVBLK;
    const int wrow = MODE == 0 ? (wid & 3) * 32 : wid * 32, khalf = MODE == 0 ? (wid >> 2) : 0;
    const int qlo = cur.P0 + wrow, qm = qlo + r32 - 4 * hi;
    char* V_lds = lds + OFF_V; char* K_lds = lds + OFF_K;
    float* ws = (float*)(lds + OFF_WS) + wid * 64; float* li_l = ws, * al_l = ws + 32; float* Fl = (float*)(lds + OFF_FL);
    float m_reg = -1e30f, l_reg = 0; f32x16 o[4] = {};
    const int sr = tid >> 4, sc = (tid & 15) * 8, vst0 = v_st(sr, sc), vst1 = v_st(32 + sr, sc), kws = KSWZ(sr, sc * 2);
    const int vb0 = (int)(uintptr_t)lds + v_rd_base(lane);
    const bf16* Kh = cur.K; const bf16* Vh = cur.V; const float* Fh = cur.F;
    float fref = 0.f, frefn = 0.f;
    if constexpr (MODE == 1) { fref = ld_agent(cur.F + cur.P0); frefn = ld_agent(nxt.F + nxt.P0); }
#define RESC(a) do { if (__any((a) < 1.f)) { if (hi == 0) al_l[r32] = (a); asm volatile("s_waitcnt lgkmcnt(0)" ::: "memory");              \
                     for (int d_ = 0; d_ < 4; ++d_) for (int r = 0; r < 16; ++r) o[d_][r] *= al_l[crow(r, hi)]; } } while (0)
#define KBASE(t) ((jl - (t)) * KVBLK)
#define ACT(t) (KBASE(t) <= qlo + (MODE == 0 ? 0 : 31))
#define MASKT(P0_, P1_, t) do { if constexpr (MODE == 1) { const int kb_ = KBASE(t); if (ACT(t) && kb_ + KVBLK - 1 > qlo) mask_tile(P0_, P1_, qm - kb_); } } while (0)
#define SEAM_K0() do { VMWN(NQL); SWRITE_HK(0, frefn); SBAR(); } while (0)
    f32x16 pA0, pA1, pB0, pB1; float mnA, mnB, alA, alB; bf16x8 pa0, pa1, pa2, pa3;
    const char* ql = lds + OFF_XCH + wid * 8192 + lane * 16;
    if constexpr (MODE == 1) {
#pragma unroll
        for (int d0 = 0; d0 < 8; ++d0) *(bf16x8*)(lds + OFF_XCH + wid * 8192 + d0 * 1024 + lane * 16) = S.qr[d0];
    }
    SWRITE_HV(0); SBAR();
    if (NT > 1) { SLOADX(Kh, Vh, Fh, KBASE(1)); }
    SBAR(); qkt<0, MODE>(pA0, pA1, K_lds, Fl, r32, hi, S.qr, ql, ACT(0), khalf);
    MASKT(pA0, pA1, 0); partialSM(pA0, pA1, m_reg, mnA, alA);
    if (NT > 1) { VMW(); SWRITE_HV(1); SWRITE_HK(1, fref); }
    __syncthreads();
#define HALF_STEP(PX0, PX1, mnX, alX, PY0, PY1, alY, t, KB, VB, SB) do {                                                      \
        SBAR(); qkt<KB, MODE>(PX0, PX1, K_lds, Fl, r32, hi, S.qr, ql, ACT(t), khalf);                                            \
        finishSM(PY0, PY1, alY, l_reg, pa0, pa1, pa2, pa3); SBAR();                                                           \
        if ((t) + 1 < NT) { SLOADX(Kh, Vh, Fh, KBASE((t) + 1)); SBAR(); }                                                     \
        pv_tile<VB>(o, vb0, pa0, pa1, pa2, pa3, ACT((t) - 1)); MASKT(PX0, PX1, (t)); partialSM(PX0, PX1, m_reg, mnX, alX);    \
        __syncthreads();                                                                                                      \
        if ((t) + 1 < NT) { VMW(); SWRITE_HV(SB); SWRITE_HK(SB, fref); }                                                      \
        RESC(alX); __syncthreads(); } while (0)
    for (int t = 1; t + 1 < NT; t += 2) {
        HALF_STEP(pB0, pB1, mnB, alB, pA0, pA1, alA, t, 1, 0, 0);
        HALF_STEP(pA0, pA1, mnA, alA, pB0, pB1, alB, t + 1, 0, 1, 1);
    }
    const bool even = (NT & 1) == 0;
    if (even) { SBAR(); qkt<1, MODE>(pB0, pB1, K_lds, Fl, r32, hi, S.qr, ql, ACT(NT - 1), khalf); SBAR(); }
    SLOADX(nxt.K, nxt.V, nxt.F, kbn); SBAR();
    if constexpr (MODE == 0) {
#pragma unroll
        for (int d0 = 0; d0 < 4; ++d0) S.qr[d0] = load8(nxt.Q + (size_t)((wid & 3) * 32 + r32) * D + (wid >> 2) * 64 + d0 * 16 + hi * 8);
    } else {
#pragma unroll
        for (int d0 = 0; d0 < 8; ++d0) S.qr[d0] = load8(nxt.Q + (size_t)(wid * 32 + r32) * D + d0 * 16 + hi * 8);
    }
    SBAR();
    finishSM(pA0, pA1, alA, l_reg, pa0, pa1, pa2, pa3); SBAR();
    pv_tile<0>(o, vb0, pa0, pa1, pa2, pa3, ACT(even ? NT - 2 : NT - 1));
    if (even) { MASKT(pB0, pB1, NT - 1); partialSM(pB0, pB1, m_reg, mnB, alB); __syncthreads(); RESC(alB);
        finishSM(pB0, pB1, alB, l_reg, pa0, pa1, pa2, pa3); SBAR(); pv_tile<1>(o, vb0, pa0, pa1, pa2, pa3, ACT(NT - 1)); }
    SBAR(); SEAM_K0();
    if (hi == 0) li_l[r32] = l_reg; asm volatile("s_waitcnt lgkmcnt(0)" ::: "memory");
    float rli[16];
#pragma unroll
    for (int r = 0; r < 16; ++r) rli[r] = __builtin_amdgcn_rcpf(li_l[crow(r, hi)]);
    bf16* Ow = cur.O + (size_t)wrow * D;
    if constexpr (MODE == 0) {
        float* xch = (float*)(lds + OFF_XCH) + (wid & 3) * 4096 + lane;
        if (wid >= 4) {
#pragma unroll
            for (int d0 = 0; d0 < 4; ++d0)
#pragma unroll
                for (int r = 0; r < 16; ++r) xch[(d0 * 16 + r) * 64] = o[d0][r] * rli[r];
        }
        __syncthreads();
        if (wid < 4) {
            float ss[16];
#pragma unroll
            for (int r = 0; r < 16; ++r) { float a = 0.f;
#pragma unroll
                for (int d0 = 0; d0 < 4; ++d0) { const float v = o[d0][r] * rli[r] - lam * xch[(d0 * 16 + r) * 64]; o[d0][r] = v; a += v * v; }
                ss[r] = a; }
#pragma unroll
            for (int r = 0; r < 16; ++r) { float a = ss[r]; a += __shfl_xor(a, 1); a += __shfl_xor(a, 2); a += __shfl_xor(a, 4); a += __shfl_xor(a, 8); a += __shfl_xor(a, 16); ss[r] = a; }
            float g4[4];
#pragma unroll
            for (int d0 = 0; d0 < 4; ++d0) g4[d0] = gsub[d0 * 32 + r32] * 0.8f;
#pragma unroll
            for (int r = 0; r < 16; ++r) { const int orow = crow(r, hi); const float rstd = 1.0f / sqrtf(ss[r] * (1.0f / 128.0f) + 1e-5f);
#pragma unroll
                for (int d0 = 0; d0 < 4; ++d0) { const float v = o[d0][r] * rstd * g4[d0]; const float vn = __shfl_xor(v, 1);
                    if ((r32 & 1) == 0) *(unsigned*)(Ow + (size_t)orow * D + d0 * 32 + r32) = cvtpk(v, vn); } }
        }
    } else {
#pragma unroll
        for (int r = 0; r < 16; ++r) { const int orow = crow(r, hi);
#pragma unroll
            for (int d0 = 0; d0 < 4; ++d0) { const float v = o[d0][r] * rli[r]; const float vn = __shfl_xor(v, 1);
                if ((r32 & 1) == 0) *(unsigned*)(Ow + (size_t)orow * D + d0 * 32 + r32) = cvtpk(v, vn); } }
    }
    __syncthreads();
#undef RESC
#undef KBASE
#undef ACT
#undef MASKT
#undef SEAM_K0
#undef HALF_STEP
}
#undef ROW
#undef VMW
#undef VMWN
#undef SLOADX
#undef SWRITE_HK
#undef SWRITE_HV
#undef SBAR
#undef KSWZ
}

constexpr int NWAVES = 8;
#ifndef MK_N_LAUNCHES
#define MK_N_LAUNCHES 1
#endif
constexpr int PER_PHASE = 8;
constexpr int N_LAUNCHES = MK_N_LAUNCHES;

constexpr size_t MiB = 1u << 20;
constexpr size_t WS_CTL = 0, CTL_ZERO_BYTES = 1 * MiB;
constexpr size_t WS_WQKV = 1 * MiB;
constexpr size_t WS_WG = 13 * MiB;
constexpr size_t WS_WAB = 21 * MiB;
constexpr size_t WS_WO = 25 * MiB;
constexpr size_t WS_COS = 27 * MiB, WS_SIN = 29 * MiB;
constexpr size_t WS_LOGF = 31 * MiB;
constexpr size_t WS_CUMF = 31 * MiB + 512 * 1024;
constexpr size_t WS_MODP = 32 * MiB;
constexpr size_t WS_GATE = 32 * MiB + 512 * 1024;
constexpr size_t WS_PS = 33 * MiB;
constexpr size_t WS_XN = 34 * MiB;
constexpr size_t WS_QA = 66 * MiB, WS_KA = 98 * MiB, WS_VA = 130 * MiB, WS_QB = 162 * MiB, WS_X5 = 194 * MiB, WS_PN = 226 * MiB, WS_END = 230 * MiB;
constexpr size_t WS_G = WS_KA;
constexpr size_t WS_SA = WS_X5;
constexpr int CW_TMO = 0, CW_CODE = 1, CW_BAR = 4096, CW_Q = 8192;

constexpr int RING_OFF = 0, RING_BYTES = 135168;
constexpr int LDSCTL_OFF = RING_BYTES, MISC_OFF = LDSCTL_OFF + 320;
constexpr int LDS_BYTES = 147456;
static_assert(MISC_OFF + 128 <= LDS_BYTES && att::LDS_NEED <= RING_BYTES && pg8::STAGE_BYTES <= RING_BYTES, "LDS map");

#define GAS __attribute__((address_space(1)))
#define LAS __attribute__((address_space(3)))
typedef unsigned short bf16;
typedef unsigned v4u __attribute__((ext_vector_type(4)));
typedef float f32x4 __attribute__((ext_vector_type(4)));
typedef short bf16x8 __attribute__((ext_vector_type(8)));
typedef GAS unsigned gu32;
typedef GAS unsigned long long gu64;
#define RLX_AGENT __ATOMIC_RELAXED, __HIP_MEMORY_SCOPE_AGENT
#define LDS_WAIT() asm volatile("s_waitcnt lgkmcnt(0)" ::: "memory")
#define VM_WAIT() asm volatile("s_waitcnt vmcnt(0)" ::: "memory")
__device__ __forceinline__ unsigned long long rt() { return __builtin_amdgcn_s_memrealtime(); }
__device__ __forceinline__ unsigned f2bf(float f) { unsigned u = __builtin_bit_cast(unsigned, f); return (u + 0x7fffu + ((u >> 16) & 1u)) >> 16; }
__device__ __forceinline__ unsigned pk2(float lo, float hi) { return f2bf(lo) | (f2bf(hi) << 16); }

#define XB_TMO      128
#define XB_XCNT(j)  (256  + 64 * (j))
#define XB_XSUB(j)  (1280 + 64 * (j))
#define XB_XGEN(j)  (2304 + 64 * (j))
#define XB_TOP      3328
#define XB_TOPGEN   3392
#define XCD_BAR_WORDS 3456
#define XB_SPIN_CAP (1u << 18)

__device__ __forceinline__ unsigned xb_ld(unsigned* p)              { return __hip_atomic_load(p, __ATOMIC_RELAXED, __HIP_MEMORY_SCOPE_AGENT); }
__device__ __forceinline__ unsigned xb_add(unsigned* p, unsigned v) { return __hip_atomic_fetch_add(p, v, __ATOMIC_RELAXED, __HIP_MEMORY_SCOPE_AGENT); }
__device__ __forceinline__ unsigned xb_xcc_id() { return (unsigned)__builtin_amdgcn_s_getreg((3 << 11) | 20) & 0xFu; }
#define XB_SPIN(cond, bar) do { unsigned _sp = 0; while (cond) { __builtin_amdgcn_s_sleep(1); \
    if ((++_sp & 255u) == 0u) { if (xb_ld(&(bar)[XB_TMO])) break; if (_sp > XB_SPIN_CAP) { atomicAdd(&(bar)[XB_TMO], 1u); break; } } } } while (0)

struct XcdBarrier {
    unsigned* bar; unsigned x;
    volatile LAS unsigned* st;
};

__device__ __forceinline__ XcdBarrier xcd_barrier_post(unsigned* bar, volatile LAS unsigned* st) {
    XcdBarrier b; b.bar = bar; b.x = xb_xcc_id(); b.st = st;
    if (threadIdx.x == 0) (void)xb_add(&bar[XB_XCNT(b.x)], 1u);
    return b;
}
__device__ __forceinline__ void xcd_barrier_complete(unsigned* bar, unsigned x, unsigned& nloc, unsigned& nx) {
    const unsigned G = gridDim.x * gridDim.y * gridDim.z;
    unsigned sum, cnt, mine, sp = 0u;
    for (;;) {
        sum = 0u; cnt = 0u; mine = 0u;
#pragma unroll
        for (unsigned j = 0; j < 16; ++j) { const unsigned c = xb_ld(&bar[XB_XCNT(j)]); sum += c; cnt += (c > 0u) ? 1u : 0u; mine = (j == x) ? c : mine; }
        if (sum == G) break;
        __builtin_amdgcn_s_sleep(1);
        if ((++sp & 255u) == 0u) { if (xb_ld(&bar[XB_TMO])) break; if (sp > XB_SPIN_CAP) { atomicAdd(&bar[XB_TMO], 1u); break; } }
    }
    nloc = mine > 0u ? mine : 1u; nx = cnt > 0u ? cnt : 1u;
}

__device__ __forceinline__ void xcd_barrier(const XcdBarrier& b) {
    asm volatile("s_waitcnt vmcnt(0)" ::: "memory");
    __syncthreads();
    if (threadIdx.x == 0) {
        unsigned* bar = b.bar;
        __builtin_amdgcn_s_waitcnt(0);
        unsigned nloc = b.st[0], nx = b.st[1];
        if (nloc == 0u) { xcd_barrier_complete(bar, b.x, nloc, nx); b.st[0] = nloc; b.st[1] = nx; }
        const unsigned old = xb_add(&bar[XB_XSUB(b.x)], 1u);
        const unsigned gen = old / nloc;
        if (old + 1u == (gen + 1u) * nloc) {
            __builtin_amdgcn_fence(__ATOMIC_RELEASE, "agent");
            asm volatile("s_waitcnt vmcnt(0)" ::: "memory");
            const unsigned og = xb_add(&bar[XB_TOP], 1u);
            const unsigned tg = og / nx;
            if (og + 1u == (tg + 1u) * nx) xb_add(&bar[XB_TOPGEN], 1u);
            else XB_SPIN(xb_ld(&bar[XB_TOPGEN]) == tg, bar);
            __builtin_amdgcn_fence(__ATOMIC_ACQUIRE, "agent");
            xb_add(&bar[XB_XGEN(b.x)], 1u);
            asm volatile("s_waitcnt vmcnt(0)" ::: "memory");
        } else {
            XB_SPIN(xb_ld(&bar[XB_XGEN(b.x)]) == gen, bar);
            __builtin_amdgcn_fence(__ATOMIC_ACQUIRE, "agent");
            asm volatile("s_waitcnt vmcnt(0)" ::: "memory");
        }
    }
    __syncthreads();
}

struct Frame {
    LAS unsigned char* lds;
    volatile LAS unsigned* MISC;
    gu32* ctl;
    int tid, lane, wave;
    int vcu, G;
};
__device__ __forceinline__ float wave_sum(float v) {
#pragma unroll
    for (int o = 1; o < 64; o <<= 1) v += __shfl_xor(v, o);
    return v;
}
__device__ const float INV_FREQ[32] = {
    1.000000000e+00f, 7.498942018e-01f, 5.623413324e-01f, 4.216965139e-01f, 3.162277639e-01f, 2.371373773e-01f, 1.778279394e-01f, 1.333521456e-01f, 1.000000015e-01f, 7.498942316e-02f, 5.623413250e-02f, 4.216964915e-02f, 3.162277490e-02f, 2.371373773e-02f, 1.778279431e-02f, 1.333521400e-02f, 9.999999776e-03f, 7.498942316e-03f, 5.623413250e-03f, 4.216964822e-03f, 3.162277630e-03f, 2.371373819e-03f, 1.778279431e-03f, 1.333521446e-03f, 1.000000047e-03f, 7.498941850e-04f, 5.623413017e-04f, 4.216965172e-04f, 3.162277571e-04f, 2.371373703e-04f, 1.778279402e-04f, 1.333521504e-04f };
__device__ __forceinline__ void sincos_d(float angf, float& c, float& s) {
    const double a = (double)angf;
    const double k = __builtin_rint(a * 0.63661977236758134308);
    double r = __builtin_fma(-k, 1.57079632679489655800e+00, a); r = __builtin_fma(-k, 6.12323399573676603587e-17, r);
    const double r2 = r * r;
    double sp = -7.6471637318198164759e-13; sp = sp * r2 + 1.6059043836821614599e-10; sp = sp * r2 - 2.5052108385441718775e-08; sp = sp * r2 + 2.7557319223985890653e-06;
    sp = sp * r2 - 1.9841269841269841270e-04; sp = sp * r2 + 8.3333333333333333333e-03; sp = sp * r2 - 1.6666666666666666667e-01; const double sn = r + r * r2 * sp;
    double cp = 4.7794773323873852974e-14; cp = cp * r2 - 1.1470745597729724714e-11; cp = cp * r2 + 2.0876756987868098979e-09; cp = cp * r2 - 2.7557319223985890653e-07;
    cp = cp * r2 + 2.4801587301587301587e-05; cp = cp * r2 - 1.3888888888888888889e-03; cp = cp * r2 + 4.1666666666666666667e-02; cp = cp * r2 - 0.5; const double cs = 1.0 + r2 * cp;
    const int q = ((int)(long long)k) & 3;
    const double sv = (q == 0) ? sn : (q == 1) ? cs : (q == 2) ? -sn : -cs;
    const double cv = (q == 0) ? cs : (q == 1) ? -sn : (q == 2) ? -cs : sn;
    c = (float)cv; s = (float)sv;
}
__device__ __forceinline__ void p0_tr_item(const float* W, int ldw, int dst_pitch, int dst_koff, bf16* WT, int mode, LAS float* scr, int item, int nblk, int lane) {
    const int kb = item / nblk, nb = item % nblk, k0 = 64 * kb, n0 = 32 * nb;
    const int nn = n0 + (lane & 31); int sc = nn;
    if (mode == 1) { const int type = nn >> 10, j = nn & 1023, sblk = type < 3 ? type : type + 1; int jj = j;
        if (type < 2) { const int g = j >> 6, p = j & 63; jj = g * 64 + (p & 1) * 32 + (p >> 1); }
        sc = sblk * 1024 + jj; }
    else if (mode == 2) { const int type = nn >> 10, j = nn & 1023; sc = type == 0 ? 3 * 1024 + j : type == 1 ? 7 * 1024 + j : type == 2 ? 8200 + j : 9224 + j; }
#pragma unroll 8
    for (int i = 0; i < 32; ++i) { const int kk = 2 * i + (lane >> 5); scr[kk * 33 + (lane & 31)] = W[(size_t)(k0 + kk) * ldw + sc]; }
    LDS_WAIT(); asm volatile("" ::: "memory");
    const int c = lane & 7;
#pragma unroll
    for (int j = 0; j < 4; ++j) { const int n = (lane >> 3) + 8 * j; const LAS float* s = scr + (8 * c) * 33 + n;
        v4u o; o.x = pk2(s[0 * 33], s[1 * 33]); o.y = pk2(s[2 * 33], s[3 * 33]); o.z = pk2(s[4 * 33], s[5 * 33]); o.w = pk2(s[6 * 33], s[7 * 33]);
        *(GAS v4u*)(WT + (size_t)(n0 + n) * dst_pitch + dst_koff + k0 + 8 * c) = o; }
    LDS_WAIT(); asm volatile("" ::: "memory");
}
struct Args { const float* x; const float* c; const int* pos; const float* w_ada; const float* b_ada; const float* g_norm; const float* w_in; const float* b_forget;
              const float* lq1; const float* lk1; const float* lq2; const float* lk2; const float* g_subln; const float* w_a; const float* w_b; const float* w_out; const float* g_final;
              float* out; unsigned char* ws; int ph_lo, ph_hi, li, pad; };

__global__ void __launch_bounds__(NWAVES * 64, 2) fwd_kernel(Args args) {
    extern __shared__ __attribute__((aligned(16))) unsigned char lds[];
    Frame F;
    F.lds = (LAS unsigned char*)lds;
    F.MISC = (volatile LAS unsigned*)(F.lds + MISC_OFF);
    F.tid = threadIdx.x; F.lane = F.tid & 63; F.wave = __builtin_amdgcn_readfirstlane(F.tid >> 6);
    F.G = gridDim.x; { const int bx = blockIdx.x; F.vcu = (F.G % 8 == 0) ? (bx % 8) * (F.G / 8) + bx / 8 : bx; }
    unsigned char* ws = args.ws;
    F.ctl = (gu32*)(ws + WS_CTL);
    for (int u = F.tid; u < (LDS_BYTES - LDSCTL_OFF) / 4; u += NWAVES * 64) ((LAS unsigned*)(F.lds + LDSCTL_OFF))[u] = 0u;
    __syncthreads();
    XcdBarrier bar; bar.bar = (unsigned*)(F.ctl + CW_BAR); bar.x = 0; bar.st = nullptr;
    if (N_LAUNCHES != PER_PHASE) bar = xcd_barrier_post((unsigned*)(F.ctl + CW_BAR), F.MISC + 8);
#define GRID_BAR(seam) do { if (N_LAUNCHES == PER_PHASE) { if (F.tid == 0) __hip_atomic_store(F.ctl + CW_TMO, 0xBADBA0u | (unsigned)(seam), RLX_AGENT); } else { xcd_barrier(bar); } } while (0)
    const int lo = args.ph_lo, hi = args.ph_hi;
#ifndef PHASE_MASK
#define PHASE_MASK 0xff
#endif
#define IN(k) (((PHASE_MASK >> (k)) & 1) && lo <= (k) && (k) < hi)
#define BOTH(k) (IN(k) && IN((k) + 1))
    bf16* const WQKV_T = (bf16*)(ws + WS_WQKV); bf16* const WG_T = (bf16*)(ws + WS_WG); bf16* const WAB_T = (bf16*)(ws + WS_WAB); bf16* const WO_T = (bf16*)(ws + WS_WO);
    float* const COS_T = (float*)(ws + WS_COS); float* const SIN_T = (float*)(ws + WS_SIN); float* const LOGF = (float*)(ws + WS_LOGF); float* const CUMF = (float*)(ws + WS_CUMF);
    float* const PN = (float*)(ws + WS_PN); float* const MODP = (float*)(ws + WS_MODP); float* const GATE = (float*)(ws + WS_GATE); float* const PS = (float*)(ws + WS_PS);
    bf16* const XN = (bf16*)(ws + WS_XN); bf16* const QAt = (bf16*)(ws + WS_QA); bf16* const KAt = (bf16*)(ws + WS_KA); bf16* const VAt = (bf16*)(ws + WS_VA); bf16* const QBt = (bf16*)(ws + WS_QB);
    bf16* const KBt = (bf16*)args.out; bf16* const VBt = (bf16*)((unsigned char*)args.out + 32 * MiB);
    bf16* const Gt = (bf16*)(ws + WS_G); bf16* const SAt = (bf16*)(ws + WS_SA); bf16* const SBt = (bf16*)args.out; bf16* const MGt = XN;
    const int gw = F.vcu * NWAVES + F.wave, NGW = F.G * NWAVES;

    if (IN(0)) {
        LAS float* scr = (LAS float*)(F.lds + RING_OFF + F.wave * 16384);
        constexpr int I_QKV = 16 * 192, I_G = 16 * 128, I_A = 16 * 32, I_B = 16 * 32, I_O = 16 * 32, I_MOD = 48 * 16, I_ROPE = 1024;
        constexpr int NITEMS = I_QKV + I_G + I_A + I_B + I_O + I_MOD + I_ROPE;
        for (int it = gw; it < NITEMS; it += NGW) {
            int r = it;
            if (r < I_QKV) { p0_tr_item(args.w_in, N_IN, 1024, 0, WQKV_T, 1, scr, r, 192, F.lane); continue; } r -= I_QKV;
            if (r < I_G) { p0_tr_item(args.w_in, N_IN, 1024, 0, WG_T, 2, scr, r, 128, F.lane); continue; } r -= I_G;
            if (r < I_A) { p0_tr_item(args.w_a, 1024, 2048, 0, WAB_T, 0, scr, r, 32, F.lane); continue; } r -= I_A;
            if (r < I_B) { p0_tr_item(args.w_b, 1024, 2048, 1024, WAB_T, 0, scr, r, 32, F.lane); continue; } r -= I_B;
            if (r < I_O) { p0_tr_item(args.w_out, 1024, 1024, 0, WO_T, 0, scr, r, 32, F.lane); continue; } r -= I_O;
            if (r < I_MOD) { const int chunk = r % 48, ks = r / 48, col = chunk * 64 + F.lane; float a0 = 0.f, a1 = 0.f;
#pragma unroll 8
                for (int k = ks * 64; k < ks * 64 + 64; ++k) { const float w = args.w_ada[(size_t)k * 3072 + col]; const float c0 = args.c[k], c1 = args.c[1024 + k];
                    a0 += (c0 / (1.0f + expf(-c0))) * w; a1 += (c1 / (1.0f + expf(-c1))) * w; }
                MODP[(size_t)(ks * 2 + 0) * 3072 + col] = a0; MODP[(size_t)(ks * 2 + 1) * 3072 + col] = a1; continue; } r -= I_MOD;
            {
#pragma unroll 1
                for (int j = 0; j < 8; ++j) { const int idx = r * 512 + j * 64 + F.lane, m = idx >> 5, i = idx & 31;
                    const float ang = __fmul_rn((float)args.pos[m], INV_FREQ[i]); float c, s; sincos_d(ang, c, s); COS_T[idx] = c; SIN_T[idx] = s; } }
        }
        if (BOTH(0)) GRID_BAR(0);
    }
    if (IN(1)) {
        LAS float* gs = (LAS float*)(F.lds); LAS float* sh = gs + 2048; LAS float* wf = sh + 2048;
        for (int e = F.tid; e < 2048; e += NWAVES * 64) { const int b = e >> 10, k = e & 1023; float shv = args.b_ada[k], scv = args.b_ada[1024 + k];
            for (int ks = 0; ks < 16; ++ks) { shv += MODP[(size_t)(ks * 2 + b) * 3072 + k]; scv += MODP[(size_t)(ks * 2 + b) * 3072 + 1024 + k]; }
            gs[e] = args.g_norm[k] * (1.0f + scv); sh[e] = shv;
            if (blockIdx.x == 0) { float gv = args.b_ada[2048 + k]; for (int ks = 0; ks < 16; ++ks) gv += MODP[(size_t)(ks * 2 + b) * 3072 + 2048 + k]; GATE[e] = gv; } }
        for (int e = F.tid; e < 8192; e += NWAVES * 64) { const int k = e >> 3, j = e & 7; wf[j * 1024 + k] = args.w_in[(size_t)k * N_IN + 8192 + j]; }
        __syncthreads();
        for (int m = gw; m < M; m += NGW) { const int b = m >> 13;
            const GAS f32x4* xr = (const GAS f32x4*)(args.x + (size_t)m * DM) + F.lane;
            f32x4 v[4]; float s = 0.f;
#pragma unroll
            for (int j = 0; j < 4; ++j) { v[j] = xr[64 * j]; s += (v[j].x * v[j].x + v[j].y * v[j].y) + (v[j].z * v[j].z + v[j].w * v[j].w); }
            const float rstd = 1.0f / sqrtf(wave_sum(s) * (1.0f / DM) + 1e-6f);
            float fl[8];
#pragma unroll
            for (int jj = 0; jj < 8; ++jj) fl[jj] = 0.f;
            GAS unsigned long long* o8 = (GAS unsigned long long*)(XN + (size_t)m * DM) + F.lane;
#pragma unroll
            for (int j = 0; j < 4; ++j) { const int k = 256 * j + 4 * F.lane;
                const f32x4 g4 = *(const LAS f32x4*)(gs + b * 1024 + k), s4 = *(const LAS f32x4*)(sh + b * 1024 + k);
                f32x4 h; h.x = v[j].x * rstd * g4.x + s4.x; h.y = v[j].y * rstd * g4.y + s4.y; h.z = v[j].z * rstd * g4.z + s4.z; h.w = v[j].w * rstd * g4.w + s4.w;
#pragma unroll
                for (int jj = 0; jj < 8; ++jj) { const f32x4 w4 = *(const LAS f32x4*)(wf + jj * 1024 + k); fl[jj] += (h.x * w4.x + h.y * w4.y) + (h.z * w4.z + h.w * w4.w); }
                o8[64 * j] = (unsigned long long)pk2(h.x, h.y) | ((unsigned long long)pk2(h.z, h.w) << 32); }
            float mine = 0.f;
#pragma unroll
            for (int jj = 0; jj < 8; ++jj) { const float t = wave_sum(fl[jj]); if (F.lane == jj) mine = t; }
            if (F.lane < 8) { const float z = mine + args.b_forget[F.lane]; LOGF[(size_t)m * 8 + F.lane] = fminf(z, 0.f) - log1pf(expf(-fabsf(z))); }
        }
        if (BOTH(1)) GRID_BAR(1);
    }
    if (IN(2)) {
        if (blockIdx.x < 16) { const int bh = blockIdx.x, b = bh >> 3, h = bh & 7; LAS double* wt = (LAS double*)(F.lds);
            double pre[16]; double run = 0.0;
#pragma unroll
            for (int i = 0; i < 16; ++i) { run += (double)LOGF[((size_t)b * SEQ + F.tid * 16 + i) * 8 + h]; pre[i] = run; }
            double inc = run;
#pragma unroll
            for (int o = 1; o < 64; o <<= 1) { const double t = __shfl_up(inc, o); if (F.lane >= o) inc += t; }
            if (F.lane == 63) wt[F.wave] = inc;
            __syncthreads();
            double base = inc - run;
            for (int w = 0; w < F.wave; ++w) base += wt[w];
#pragma unroll
            for (int i = 0; i < 16; ++i) CUMF[(size_t)bh * SEQ + F.tid * 16 + i] = (float)(base + pre[i]);
            __syncthreads(); }
        pg8::Gemm g{XN, WQKV_T, M, 6144, DM}; pg8::StaticOrder S; S.init(M, 6144, F.G, (int)blockIdx.x);
        pg8::EpiQKV E{QAt, KAt, VAt, QBt, KBt, VBt, COS_T, SIN_T, PN};
        pg8::gemm_phase<pg8::EpiQKV, pg8::StaticOrder, true, true>(F.lds + RING_OFF, g, S, E);
        if (BOTH(2)) GRID_BAR(2);
    }
    if (IN(3)) {
        float s1 = 0.f, s2 = 0.f;
        for (int i = 0; i < 64; ++i) { s1 += args.lq1[i] * args.lk1[i]; s2 += args.lq2[i] * args.lk2[i]; }
        const float lam = expf(s1) - expf(s2) + 0.2f;
        const int g = blockIdx.x & 7; gu32* qctr = F.ctl + CW_Q + 64 * g; volatile LAS unsigned* qw = F.MISC + 16;
        char* albs = (char*)lds + RING_OFF;
#define PULL(dst) do { if (F.tid == 0) qw[0] = xb_add((unsigned*)qctr, 1u); __syncthreads(); dst = (int)qw[0]; __syncthreads(); } while (0)
#define REF_B(r, ix) do { const int bh_ = 2 * g + (ix) / 32, qb_ = 31 - ((ix) % 32); r.P0 = qb_ * 256; r.Q = QBt + ((size_t)bh_ * SEQ + r.P0) * HD; r.O = QBt + ((size_t)bh_ * SEQ + r.P0) * HD; \
        r.K = KBt + (size_t)bh_ * SEQ * HD; r.V = VBt + (size_t)bh_ * SEQ * HD; r.F = CUMF + (size_t)bh_ * SEQ; } while (0)
#define REF_A(r, ix) do { const int bh_ = 2 * g + (ix) / 64, qb_ = 63 - ((ix) % 64); r.P0 = qb_ * 128; r.Q = QAt + ((size_t)bh_ * SEQ + r.P0) * HD; r.O = QAt + ((size_t)bh_ * SEQ + r.P0) * HD; \
        r.K = KAt + (size_t)bh_ * SEQ * HD; r.V = VAt + (size_t)bh_ * SEQ * HD; r.F = CUMF; } while (0)
        float bnd[2];
        { volatile LAS float* red = (volatile LAS float*)(F.lds + RING_OFF);
          for (int hl = 0; hl < 2; ++hl) { float mx[2];
              for (int t2 = 0; t2 < 2; ++t2) { float m_ = 0.f; const GAS f32x4* pn = (const GAS f32x4*)(PN + ((size_t)t2 * 16 * SEQ + (size_t)(2 * g + hl) * SEQ) * 4);
                  for (int r = F.tid; r < SEQ; r += NWAVES * 64) { const f32x4 v = pn[r]; m_ = fmaxf(m_, (v.x + v.y) + (v.z + v.w)); }
#pragma unroll
                  for (int o = 1; o < 64; o <<= 1) m_ = fmaxf(m_, __shfl_xor(m_, o));
                  if (F.lane == 0) red[(hl * 2 + t2) * 8 + F.wave] = m_; }
          }
          __syncthreads();
          for (int hl = 0; hl < 2; ++hl) { float q2 = 0.f, k2 = 0.f;
              for (int w = 0; w < 8; ++w) { q2 = fmaxf(q2, red[(hl * 2 + 0) * 8 + w]); k2 = fmaxf(k2, red[(hl * 2 + 1) * 8 + w]); }
              bnd[hl] = (2.04f * sqrtf(q2 * k2) + 175.0f) * 0.6931471805599453f; }
          __syncthreads(); }
        int idx; PULL(idx);
#ifndef ATT_MASK
#define ATT_MASK 3
#endif
        if ((ATT_MASK & 2) && idx < 64) { att::BlockRef cur, nxt; REF_B(cur, idx); att::Seam S; att::attn_prime<1>(cur, albs, S);
            int ntc = att::fox_nt(cur.F, cur.P0, (idx / 32) ? bnd[1] : bnd[0]);
            for (;;) { int nidx; PULL(nidx); const bool more = nidx < 64; nxt = cur; int ntn = ntc; if (more) { REF_B(nxt, nidx); ntn = att::fox_nt(nxt.F, nxt.P0, (nidx / 32) ? bnd[1] : bnd[0]); }
                att::attn_block<1>(cur, nxt, ntc, lam, args.g_subln, albs, S); idx = nidx; if (!more) break; cur = nxt; ntc = ntn; } }
        if ((ATT_MASK & 1) && idx < 192) { att::BlockRef cur, nxt; REF_A(cur, idx - 64); att::Seam S; att::attn_prime<0>(cur, albs, S);
            for (;;) { int nidx; PULL(nidx); const bool more = nidx < 192; nxt = cur; if (more) REF_A(nxt, nidx - 64);
                att::attn_block<0>(cur, nxt, cur.P0 / 64 + 2, lam, args.g_subln, albs, S); idx = nidx; if (!more) break; cur = nxt; } }
#undef PULL
#undef REF_A
#undef REF_B
        if (BOTH(3)) GRID_BAR(3);
    }
    if (IN(4)) {
        pg8::Gemm g{XN, WG_T, M, 4096, DM}; pg8::StaticOrder S; S.init(M, 4096, F.G, (int)blockIdx.x);
        pg8::EpiGate E{QAt, QBt, Gt, SAt, SBt};
        pg8::gemm_phase<pg8::EpiGate, pg8::StaticOrder, true, true>(F.lds + RING_OFF, g, S, E);
        if (BOTH(4)) GRID_BAR(4);
    }
    if (IN(5)) {
        pg8::Gemm g{Gt, WAB_T, M, 1024, 2048}; pg8::StaticOrder S; S.init(M, 1024, F.G, (int)blockIdx.x);
        pg8::EpiMerge E{SAt, SBt, MGt};
        pg8::gemm_phase<pg8::EpiMerge, pg8::StaticOrder, true, true>(F.lds + RING_OFF, g, S, E);
        if (BOTH(5)) GRID_BAR(5);
    }
    if (IN(6)) {
        pg8::Gemm g{MGt, WO_T, M, 1024, DM}; pg8::StaticOrder S; S.init(M, 1024, F.G, (int)blockIdx.x);
        pg8::EpiOut E{args.x, args.out, GATE, PS};
        pg8::gemm_phase<pg8::EpiOut, pg8::StaticOrder, true, true>(F.lds + RING_OFF, g, S, E);
        if (BOTH(6)) GRID_BAR(6);
    }
    if (IN(7)) {
        for (int m = gw; m < M; m += NGW) {
            float p = F.lane < 16 ? PS[(size_t)m * 16 + F.lane] : 0.f; p = wave_sum(p);
            const float rstd = 1.0f / sqrtf(p * (1.0f / DM) + 1e-6f);
            GAS f32x4* orow = (GAS f32x4*)(args.out + (size_t)m * DM) + F.lane; const GAS f32x4* gf = (const GAS f32x4*)args.g_final + F.lane;
#pragma unroll
            for (int j = 0; j < 4; ++j) { f32x4 v = orow[64 * j]; const f32x4 g4 = gf[64 * j]; v.x *= rstd * g4.x; v.y *= rstd * g4.y; v.z *= rstd * g4.z; v.w *= rstd * g4.w; orow[64 * j] = v; }
        }
    }
#undef IN
#undef BOTH
#undef GRID_BAR
}

extern "C" void kernel_launch(void* const* d_in, const int* in_sizes, int n_in, void* d_out, int out_size, void* d_ws, size_t ws_size, hipStream_t stream) {
    static int grid = 0;
    if (grid == 0) {
        if (n_in != 17 || in_sizes[0] != M * DM || out_size != M * DM || ws_size < WS_END) { fprintf(stderr, "kernel_launch: unexpected shapes (n_in %d, in0 %d, out %d, ws %zu); nothing launched\n", n_in, n_in > 0 ? in_sizes[0] : -1, out_size, ws_size); grid = -1; return; }
        int dev = 0, cus = 0;
        if (hipGetDevice(&dev) != hipSuccess || hipDeviceGetAttribute(&cus, hipDeviceAttributeMultiprocessorCount, dev) != hipSuccess) { fprintf(stderr, "kernel_launch: device query failed\n"); grid = -1; return; }
        if (hipFuncSetAttribute((const void*)fwd_kernel, hipFuncAttributeMaxDynamicSharedMemorySize, LDS_BYTES) != hipSuccess) { fprintf(stderr, "kernel_launch: hipFuncSetAttribute failed\n"); grid = -1; return; }
        int per_cu = 0;
        if (hipOccupancyMaxActiveBlocksPerMultiprocessor(&per_cu, (const void*)fwd_kernel, NWAVES * 64, LDS_BYTES) != hipSuccess || per_cu < 1)
            fprintf(stderr, "kernel_launch: note: occupancy query reports %d workgroups per CU\n", per_cu);
        (void)hipGetLastError();
        grid = cus;
    }
    if (grid < 0) return;
    if (hipMemsetAsync((char*)d_ws + WS_CTL, 0, CTL_ZERO_BYTES, stream) != hipSuccess) { fprintf(stderr, "kernel_launch: hipMemsetAsync failed\n"); return; }
    Args a{};
    a.x = (const float*)d_in[0]; a.c = (const float*)d_in[1]; a.pos = (const int*)d_in[2]; a.w_ada = (const float*)d_in[3]; a.b_ada = (const float*)d_in[4]; a.g_norm = (const float*)d_in[5];
    a.w_in = (const float*)d_in[6]; a.b_forget = (const float*)d_in[7]; a.lq1 = (const float*)d_in[8]; a.lk1 = (const float*)d_in[9]; a.lq2 = (const float*)d_in[10]; a.lk2 = (const float*)d_in[11];
    a.g_subln = (const float*)d_in[12]; a.w_a = (const float*)d_in[13]; a.w_b = (const float*)d_in[14]; a.w_out = (const float*)d_in[15]; a.g_final = (const float*)d_in[16];
    a.out = (float*)d_out; a.ws = (unsigned char*)d_ws;
    for (int li = 0; li < N_LAUNCHES; ++li) {
        a.ph_lo = (N_LAUNCHES == PER_PHASE) ? li : 0; a.ph_hi = (N_LAUNCHES == PER_PHASE) ? li + 1 : PER_PHASE; a.li = li;
        hipLaunchKernelGGL(fwd_kernel, dim3(grid), dim3(NWAVES * 64), LDS_BYTES, stream, a);
        const hipError_t le = hipPeekAtLastError();
        if (le != hipSuccess) { fprintf(stderr, "kernel_launch: launch %d failed: %s\n", li, hipGetErrorName(le)); break; }
    }
}
```

```cpp
#include <hip/hip_runtime.h>
#include <hip/hip_bf16.h>
#include <cstdio>
#include <cstdint>
#include <cmath>

constexpr int BATCH = 2, SEQ = 8192, DM = 1024, M = BATCH * SEQ, NH = 8, HD = 128, N_IN = 10248;
constexpr float LOG2E = 1.4426950408889634f;
constexpr float C2A = 0.125f * LOG2E;
constexpr float C2B = 0.08838834764831845f * LOG2E;

namespace pg8 {
#define PG8_LAS __attribute__((address_space(3)))
typedef unsigned short bf16_t;
typedef short bf16x8 __attribute__((ext_vector_type(8)));
typedef float f32x4 __attribute__((ext_vector_type(4)));
typedef unsigned u32x4 __attribute__((ext_vector_type(4)));
constexpr int BM = 256, BK = 64, HALF = 128, HTB = HALF * BK * 2  , STAGE_BYTES = 8 * HTB, NXCD = 8, WGM = 8;

__host__ __device__ __forceinline__ int lds_byte(int r, int c) { const int st = (r >> 4) * 2 + (c >> 5), rr = r & 15, cc = c & 31, ob = rr * 64 + cc * 2; return st * 1024 + (ob ^ (((ob >> 9) & 1) << 5)); }
__host__ __device__ __forceinline__ void stage_rc(int b, int& R, int& C) { const int st = b / 1024, sb = b % 1024, swz = sb ^ (((sb >> 9) & 1) << 5); R = (st >> 1) * 16 + swz / 64; C = (st & 1) * 32 + (swz % 64) / 2; }
__host__ __device__ __forceinline__ int perm32(int rho) { const int n = rho >> 4, i = rho & 15; return 8 * (i >> 2) + 4 * n + (i & 3); }

struct Unit { int pm, pn; };
struct Gemm { const bf16_t* A; const bf16_t* Bt; int M, N, K; };

struct StaticOrder {
    int nM, nN, nwg, G, c;
    __host__ __device__ void init(int M, int N, int G_, int c_) { nM = M / BM; nN = N / BM; nwg = nM * nN; G = G_; c = c_; }
    __host__ __device__ bool next(int i, Unit& u) const {
        const long L = (long)i * G + c; if (L >= nwg) return false;
        int wgid = (int)L; { const int q = nwg / NXCD, r = nwg % NXCD, xcd = wgid % NXCD, off = wgid / NXCD; wgid = (xcd < r ? xcd * (q + 1) : r * (q + 1) + (xcd - r) * q) + off; }
        const int nig = WGM * nN, gid = wgid / nig, fm = gid * WGM, gsz = (nM - fm) < WGM ? (nM - fm) : WGM;
        u.pm = fm + ((wgid % nig) % gsz); u.pn = (wgid % nig) / gsz; return true;
    }
    __device__ __forceinline__ void a_ready(const Unit&) const {}
    __device__ __forceinline__ void done(const Unit&) const {}
};
__device__ __forceinline__ unsigned cvt_pk_bf16(float lo, float hi) { unsigned r; asm volatile("v_cvt_pk_bf16_f32 %0, %1, %2" : "=v"(r) : "v"(lo), "v"(hi)); return r; }
__device__ __forceinline__ float bf_lo(unsigned w) { return __uint_as_float(w << 16); }
__device__ __forceinline__ float bf_hi(unsigned w) { return __uint_as_float(w & 0xffff0000u); }
__device__ __forceinline__ float sigm(float x) { return __builtin_amdgcn_rcpf(1.0f + __builtin_amdgcn_exp2f(-x * LOG2E)); }
__device__ __forceinline__ u32x4 pack8(const f32x4 a, const f32x4 b) { u32x4 w; w.x = cvt_pk_bf16(a[0], a[1]); w.y = cvt_pk_bf16(a[2], a[3]); w.z = cvt_pk_bf16(b[0], b[1]); w.w = cvt_pk_bf16(b[2], b[3]); return w; }

struct EpiQKV {
    static constexpr bool PERM = true, AFTER_DRAIN = false, HAS_MID = false;
    bf16_t *QA, *KA, *VA, *QB, *KB, *VB; const float* cosT; const float* sinT; float* PN;
    __device__ __forceinline__ void operator()(const f32x4 (&acc)[2][2][4][2], const Unit& u, int wr, int wc, int fr, int fq) const {
        const int type = u.pn >> 2;
        bf16_t* T = type == 0 ? QA : type == 1 ? KA : type == 2 ? VA : type == 3 ? QB : type == 4 ? KB : VB;
        const bool rope = type < 2; const float sc = type == 0 ? C2A : (type == 3 ? C2B : 1.0f);
        const int row0 = u.pm * BM + wr * 64 + fr, b = (u.pm * BM) >> 13, d = wc * 32 + 8 * fq, i0 = (wc & 1) * 16 + 4 * fq;
#pragma unroll
        for (int ai = 0; ai < 2; ++ai)
#pragma unroll
            for (int m = 0; m < 4; ++m) { const int row = row0 + ai * HALF + m * 16, s = row & (SEQ - 1);
                f32x4 c4 = {1.f, 1.f, 1.f, 1.f}, s4 = {0.f, 0.f, 0.f, 0.f};
                if (rope) { c4 = *(const f32x4*)(cosT + (size_t)row * 32 + i0); s4 = *(const f32x4*)(sinT + (size_t)row * 32 + i0); }
#pragma unroll
                for (int bj = 0; bj < 2; ++bj) { const int h = (u.pn & 3) * 2 + bj;
                    f32x4 v0 = acc[ai][bj][m][0], v1 = acc[ai][bj][m][1];
                    if (rope) { f32x4 r0, r1;
                        r0[0] = v0[0] * c4[0] - v0[1] * s4[0]; r0[1] = v0[0] * s4[0] + v0[1] * c4[0];
                        r0[2] = v0[2] * c4[1] - v0[3] * s4[1]; r0[3] = v0[2] * s4[1] + v0[3] * c4[1];
                        r1[0] = v1[0] * c4[2] - v1[1] * s4[2]; r1[1] = v1[0] * s4[2] + v1[1] * c4[2];
                        r1[2] = v1[2] * c4[3] - v1[3] * s4[3]; r1[3] = v1[2] * s4[3] + v1[3] * c4[3];
                        v0 = r0; v1 = r1; }
                    v0 = v0 * sc; v1 = v1 * sc;
                    if (type == 3 || type == 4) { float ss = (v0[0] * v0[0] + v0[1] * v0[1]) + (v0[2] * v0[2] + v0[3] * v0[3]) + (v1[0] * v1[0] + v1[1] * v1[1]) + (v1[2] * v1[2] + v1[3] * v1[3]);
                        ss += __shfl_xor(ss, 16); ss += __shfl_xor(ss, 32);
                        if (fq == 0) PN[((size_t)(type - 3) * 16 * SEQ + (size_t)(b * NH + h) * SEQ + s) * 4 + wc] = ss; }
                    *(u32x4*)(T + ((size_t)((b * NH + h) * SEQ + s)) * HD + d) = pack8(v0, v1); }
                if (m & 1) asm volatile("" ::: "memory"); }
    }
};
struct EpiGate {
    static constexpr bool PERM = true, AFTER_DRAIN = false, HAS_MID = false;
    const bf16_t *OA, *OB; bf16_t *G, *SA, *SB;
    __device__ __forceinline__ void operator()(const f32x4 (&acc)[2][2][4][2], const Unit& u, int wr, int wc, int fr, int fq) const {
        const int type = u.pn >> 2;
        const int row0 = u.pm * BM + wr * 64 + fr, b = (u.pm * BM) >> 13, d = wc * 32 + 8 * fq, n0 = (u.pn & 3) * 256 + d;
#pragma unroll
        for (int ai = 0; ai < 2; ++ai)
#pragma unroll
            for (int m = 0; m < 4; ++m) { const int row = row0 + ai * HALF + m * 16, s = row & (SEQ - 1);
#pragma unroll
                for (int bj = 0; bj < 2; ++bj) { const int h = (u.pn & 3) * 2 + bj, n = n0 + bj * HALF;
                    f32x4 v0 = acc[ai][bj][m][0], v1 = acc[ai][bj][m][1];
#pragma unroll
                    for (int j = 0; j < 4; ++j) { v0[j] = sigm(v0[j]); v1[j] = sigm(v1[j]); }
                    if (type < 2) { const bf16_t* O = type == 0 ? OA : OB;
                        const u32x4 ow = *(const u32x4*)(O + ((size_t)((b * NH + h) * SEQ + s)) * HD + d);
                        const f32x4 z0 = acc[ai][bj][m][0], z1 = acc[ai][bj][m][1];
                        v0[0] *= z0[0] * bf_lo(ow.x); v0[1] *= z0[1] * bf_hi(ow.x); v0[2] *= z0[2] * bf_lo(ow.y); v0[3] *= z0[3] * bf_hi(ow.y);
                        v1[0] *= z1[0] * bf_lo(ow.z); v1[1] *= z1[1] * bf_hi(ow.z); v1[2] *= z1[2] * bf_lo(ow.w); v1[3] *= z1[3] * bf_hi(ow.w);
                        *(u32x4*)(G + (size_t)row * 2048 + type * 1024 + n) = pack8(v0, v1); }
                    else { bf16_t* S_ = type == 2 ? SA : SB; *(u32x4*)(S_ + (size_t)row * 1024 + n) = pack8(v0, v1); } }
                asm volatile("" ::: "memory"); }
    }
};
struct EpiMerge {
    static constexpr bool PERM = true, AFTER_DRAIN = false, HAS_MID = true;
    const bf16_t *SA, *SB; bf16_t* MG;
    __device__ __forceinline__ void mid(f32x4 (&acc)[2][2][4][2], const Unit& u, int wr, int wc, int fr, int fq) const {
        int opq = 0; asm volatile("" : "+v"(opq));
        const int row0 = u.pm * BM + wr * 64 + fr + opq, c0 = u.pn * BM + wc * 32 + 8 * fq;
#pragma unroll
        for (int ai = 0; ai < 2; ++ai)
#pragma unroll
            for (int m = 0; m < 4; ++m) { const size_t ro = (size_t)(row0 + ai * HALF + m * 16) * 1024 + c0;
#pragma unroll
                for (int bj = 0; bj < 2; ++bj) { const u32x4 a = *(const u32x4*)(SA + ro + bj * HALF), bb = *(const u32x4*)(SB + ro + bj * HALF);
                    const float TINY = 8.6736174e-19f;
                    f32x4 r0, r1;
                    r0[0] = bf_lo(a.x) * __builtin_amdgcn_rcpf(fmaxf(bf_lo(bb.x), TINY)); r0[1] = bf_hi(a.x) * __builtin_amdgcn_rcpf(fmaxf(bf_hi(bb.x), TINY));
                    r0[2] = bf_lo(a.y) * __builtin_amdgcn_rcpf(fmaxf(bf_lo(bb.y), TINY)); r0[3] = bf_hi(a.y) * __builtin_amdgcn_rcpf(fmaxf(bf_hi(bb.y), TINY));
                    r1[0] = bf_lo(a.z) * __builtin_amdgcn_rcpf(fmaxf(bf_lo(bb.z), TINY)); r1[1] = bf_hi(a.z) * __builtin_amdgcn_rcpf(fmaxf(bf_hi(bb.z), TINY));
                    r1[2] = bf_lo(a.w) * __builtin_amdgcn_rcpf(fmaxf(bf_lo(bb.w), TINY)); r1[3] = bf_hi(a.w) * __builtin_amdgcn_rcpf(fmaxf(bf_hi(bb.w), TINY));
                    acc[ai][bj][m][0] = acc[ai][bj][m][0] * r0; acc[ai][bj][m][1] = acc[ai][bj][m][1] * r1; }
                asm volatile("" ::: "memory"); }
    }
    __device__ __forceinline__ void operator()(const f32x4 (&acc)[2][2][4][2], const Unit& u, int wr, int wc, int fr, int fq) const {
        const int row0 = u.pm * BM + wr * 64 + fr, c0 = u.pn * BM + wc * 32 + 8 * fq;
#pragma unroll
        for (int ai = 0; ai < 2; ++ai)
#pragma unroll
            for (int m = 0; m < 4; ++m) { const size_t ro = (size_t)(row0 + ai * HALF + m * 16) * 1024 + c0;
#pragma unroll
                for (int bj = 0; bj < 2; ++bj) { const u32x4 bb = *(const u32x4*)(SB + ro + bj * HALF);
                    const float TINY = 8.6736174e-19f;
                    f32x4 s0, s1;
                    s0[0] = fmaxf(bf_lo(bb.x), TINY); s0[1] = fmaxf(bf_hi(bb.x), TINY); s0[2] = fmaxf(bf_lo(bb.y), TINY); s0[3] = fmaxf(bf_hi(bb.y), TINY);
                    s1[0] = fmaxf(bf_lo(bb.z), TINY); s1[1] = fmaxf(bf_hi(bb.z), TINY); s1[2] = fmaxf(bf_lo(bb.w), TINY); s1[3] = fmaxf(bf_hi(bb.w), TINY);
                    *(u32x4*)(MG + ro + bj * HALF) = pack8(acc[ai][bj][m][0] * s0, acc[ai][bj][m][1] * s1); }
                asm volatile("" ::: "memory"); }
    }
};
struct EpiOut {
    static constexpr bool PERM = false, AFTER_DRAIN = false, HAS_MID = false;
    const float* x; float* out; const float* gate; float* PS;
    __device__ __forceinline__ void operator()(const f32x4 (&acc)[2][2][4][2], const Unit& u, int wr, int wc, int fr, int fq) const {
        const int row0 = u.pm * BM + wr * 64 + fr, b = (u.pm * BM) >> 13, col0 = u.pn * BM + wc * 32 + 4 * fq;
        f32x4 gv[2][2];
#pragma unroll
        for (int bj = 0; bj < 2; ++bj)
#pragma unroll
            for (int n = 0; n < 2; ++n) gv[bj][n] = *(const f32x4*)(gate + b * 1024 + col0 + bj * HALF + n * 16);
#pragma unroll
        for (int ai = 0; ai < 2; ++ai)
#pragma unroll
            for (int m = 0; m < 4; ++m) { const int row = row0 + ai * HALF + m * 16; const size_t ro = (size_t)row * 1024 + col0; float ss = 0.f;
#pragma unroll
                for (int bj = 0; bj < 2; ++bj)
#pragma unroll
                    for (int n = 0; n < 2; ++n) { const f32x4 xv = *(const f32x4*)(x + ro + bj * HALF + n * 16); const f32x4 o = xv + gv[bj][n] * acc[ai][bj][m][n];
                        ss += (o[0] * o[0] + o[1] * o[1]) + (o[2] * o[2] + o[3] * o[3]); *(f32x4*)(out + ro + bj * HALF + n * 16) = o; }
                ss += __shfl_xor(ss, 16); ss += __shfl_xor(ss, 32);
                if (fq == 0) PS[(size_t)row * 16 + u.pn * 4 + wc] = ss;
                if (m & 1) asm volatile("" ::: "memory"); }
    }
};

template <class Epi, class Sched, bool ALIGN_EPI = false, bool SP2 = false>
__device__ __forceinline__ void gemm_phase(PG8_LAS unsigned char* lds, const Gemm g, const Sched& S, const Epi& E) {
    int tid = threadIdx.x; asm volatile("" : "+v"(tid));
    const int wid = __builtin_amdgcn_readfirstlane(tid >> 6), lane = tid & 63, wr = wid >> 2, wc = wid & 3, fr = lane & 15, fq = lane >> 4;
    const int K = g.K, nt = K / BK;
    unsigned voffA[2], voffB[2];
#pragma unroll
    for (int i = 0; i < 2; ++i) { int R, C; stage_rc(tid * 16 + i * 8192, R, C); const int Rb = Epi::PERM ? ((R & ~31) + perm32(R & 31)) : R;
        voffA[i] = (unsigned)(R * K + C) * 2u; voffB[i] = (unsigned)(Rb * K + C) * 2u; }
    const size_t kstep = (size_t)(BK * 2);
    const size_t hstep = (size_t)HALF * K * 2;
    const size_t tstep = 2 * hstep;
    const unsigned ldsw = (unsigned)wid * 1024u;
    const int aoff = lds_byte(wr * 64 + fr, fq * 8), boff = lds_byte(wc * 32 + fr, fq * 8);
#define PG8_SA(b, h) (((b) * 2 + (h)) * HTB)
#define PG8_SB(b, h) ((4 + (b) * 2 + (h)) * HTB)
#define PG8_STAGE(bufoff, gbase, voff) do { _Pragma("unroll") for (int _i = 0; _i < 2; ++_i) \
        __builtin_amdgcn_global_load_lds((const unsigned*)((const char*)(gbase) + (voff)[_i]), (PG8_LAS unsigned*)(lds + (bufoff) + ldsw + _i * 8192), 16, 0, 0); } while (0)
#define PG8_LDA(dst, b, h) do { _Pragma("unroll") for (int m = 0; m < 4; ++m) _Pragma("unroll") for (int k = 0; k < 2; ++k) dst[m][k] = *(const PG8_LAS bf16x8*)(lds + PG8_SA(b, h) + aoff + m * 2048 + k * 1024); } while (0)
#define PG8_LDB(dst, b, h) do { _Pragma("unroll") for (int n = 0; n < 2; ++n) _Pragma("unroll") for (int k = 0; k < 2; ++k) dst[n][k] = *(const PG8_LAS bf16x8*)(lds + PG8_SB(b, h) + boff + n * 2048 + k * 1024); } while (0)
#define PG8_MMA(ai, bj, At, Bt) do { __builtin_amdgcn_s_setprio(1); _Pragma("unroll") for (int m = 0; m < 4; ++m) _Pragma("unroll") for (int n = 0; n < 2; ++n) _Pragma("unroll") for (int k = 0; k < 2; ++k) \
        acc[ai][bj][m][n] = __builtin_amdgcn_mfma_f32_16x16x32_bf16(Bt[n][k], At[m][k], acc[ai][bj][m][n], 0, 0, 0); __builtin_amdgcn_s_setprio(0); } while (0)
#define PG8_WAIT_V(n) asm volatile("s_waitcnt vmcnt(" #n ")" ::: "memory")
#define PG8_WAIT_L(n) asm volatile("s_waitcnt lgkmcnt(" #n ")" ::: "memory")
#define PG8_BAR __builtin_amdgcn_s_barrier()
#define PG8_SCHED __builtin_amdgcn_sched_barrier(0)
    Unit cur, nxt; int ui = 0;
    if (!S.next(0, cur)) return;
    f32x4 acc[2][2][4][2];
#pragma unroll
    for (int a = 0; a < 2; ++a)
#pragma unroll
        for (int b = 0; b < 2; ++b)
#pragma unroll
            for (int m = 0; m < 4; ++m)
#pragma unroll
                for (int n = 0; n < 2; ++n) acc[a][b][m][n] = (f32x4){0.f, 0.f, 0.f, 0.f};
    bf16x8 At[4][2], B0[2][2], B1[2][2];
    const char* cA = (const char*)g.A + (size_t)cur.pm * tstep; const char* cB = (const char*)g.Bt + (size_t)cur.pn * tstep;
    S.a_ready(cur);
    if constexpr (SP2) {
        PG8_STAGE(PG8_SB(0, 0), cB, voffB); PG8_STAGE(PG8_SB(0, 1), cB + hstep, voffB); PG8_STAGE(PG8_SA(0, 0), cA, voffA); PG8_STAGE(PG8_SA(0, 1), cA + hstep, voffA);
        if (wr == 1) PG8_BAR;
        PG8_WAIT_V(2); PG8_BAR;
        PG8_STAGE(PG8_SB(1, 0), cB + kstep, voffB); PG8_STAGE(PG8_SA(1, 0), cA + kstep, voffA); PG8_STAGE(PG8_SB(1, 1), cB + hstep + kstep, voffB);
        PG8_WAIT_V(6); PG8_BAR;
    } else {
        PG8_STAGE(PG8_SB(0, 0), cB, voffB); PG8_STAGE(PG8_SA(0, 0), cA, voffA); PG8_STAGE(PG8_SB(0, 1), cB + hstep, voffB); PG8_STAGE(PG8_SA(0, 1), cA + hstep, voffA);
        if (wr == 1) PG8_BAR;
        PG8_WAIT_V(4); PG8_BAR;
        PG8_STAGE(PG8_SB(1, 0), cB + kstep, voffB); PG8_STAGE(PG8_SA(1, 0), cA + kstep, voffA); PG8_STAGE(PG8_SB(1, 1), cB + hstep + kstep, voffB);
        PG8_WAIT_V(6); PG8_BAR;
    }
    for (;;) {
        const bool has_next = S.next(ui + 1, nxt);
        const char* nA = has_next ? (const char*)g.A + (size_t)nxt.pm * tstep : cA; const char* nB = has_next ? (const char*)g.Bt + (size_t)nxt.pn * tstep : cB;
        for (int t = 0; t < nt; t += 2) {
            const bool last = (t == nt - 2);
            const char* a1 = cA + (size_t)(t + 1) * kstep;
            const char* a2 = last ? nA : cA + (size_t)(t + 2) * kstep; const char* b2 = last ? nB : cB + (size_t)(t + 2) * kstep;
            const char* a3 = a2 + kstep; const char* b3 = b2 + kstep;
            if (last && has_next) S.a_ready(nxt);
            if constexpr (SP2) {
            PG8_LDB(B0, 0, 0); PG8_LDB(B1, 0, 1); PG8_SCHED; PG8_LDA(At, 0, 0); PG8_STAGE(PG8_SA(1, 1), a1 + hstep, voffA);
            PG8_WAIT_V(8); PG8_WAIT_L(0); PG8_BAR; PG8_MMA(0, 0, At, B0); PG8_MMA(0, 1, At, B1); PG8_BAR; PG8_SCHED;
            PG8_LDA(At, 0, 1); PG8_STAGE(PG8_SB(0, 0), b2, voffB); PG8_STAGE(PG8_SB(0, 1), b2 + hstep, voffB); PG8_STAGE(PG8_SA(0, 0), a2, voffA);
            PG8_WAIT_V(8); PG8_WAIT_L(0); PG8_BAR; PG8_MMA(1, 0, At, B0); PG8_MMA(1, 1, At, B1); PG8_BAR; PG8_SCHED;
            PG8_LDB(B0, 1, 0); PG8_LDB(B1, 1, 1); PG8_SCHED; PG8_LDA(At, 1, 0); PG8_STAGE(PG8_SA(0, 1), a2 + hstep, voffA);
            PG8_WAIT_V(8); PG8_WAIT_L(0); PG8_BAR; PG8_MMA(0, 0, At, B0); PG8_MMA(0, 1, At, B1); PG8_BAR; PG8_SCHED;
            PG8_LDA(At, 1, 1); PG8_STAGE(PG8_SB(1, 0), b3, voffB); PG8_STAGE(PG8_SB(1, 1), b3 + hstep, voffB); PG8_STAGE(PG8_SA(1, 0), a3, voffA);
            PG8_WAIT_V(8); PG8_WAIT_L(0); PG8_BAR; PG8_MMA(1, 0, At, B0); PG8_MMA(1, 1, At, B1); PG8_BAR; PG8_SCHED;
            } else {
            PG8_LDB(B0, 0, 0); PG8_SCHED; PG8_LDA(At, 0, 0); PG8_STAGE(PG8_SA(1, 1), a1 + hstep, voffA);
            PG8_WAIT_L(8); PG8_BAR; PG8_WAIT_L(0); PG8_MMA(0, 0, At, B0); PG8_BAR; PG8_SCHED;
            PG8_LDB(B1, 0, 1); PG8_STAGE(PG8_SB(0, 0), b2, voffB);
            PG8_BAR; PG8_WAIT_L(0); PG8_MMA(0, 1, At, B1); PG8_BAR;
            PG8_LDA(At, 0, 1); PG8_STAGE(PG8_SA(0, 0), a2, voffA);
            PG8_BAR; PG8_WAIT_L(0); PG8_MMA(1, 0, At, B0); PG8_BAR; PG8_SCHED;
            PG8_STAGE(PG8_SB(0, 1), b2 + hstep, voffB);
            PG8_WAIT_V(6); PG8_BAR; PG8_MMA(1, 1, At, B1); PG8_BAR;
            PG8_LDB(B0, 1, 0); PG8_SCHED; PG8_LDA(At, 1, 0); PG8_STAGE(PG8_SA(0, 1), a2 + hstep, voffA);
            PG8_WAIT_L(8); PG8_BAR; PG8_WAIT_L(0); PG8_MMA(0, 0, At, B0); PG8_BAR; PG8_SCHED;
            PG8_LDB(B1, 1, 1); PG8_STAGE(PG8_SB(1, 0), b3, voffB);
            PG8_BAR; PG8_WAIT_L(0); PG8_MMA(0, 1, At, B1); PG8_BAR;
            PG8_LDA(At, 1, 1); PG8_STAGE(PG8_SA(1, 0), a3, voffA);
            PG8_BAR; PG8_WAIT_L(0); PG8_MMA(1, 0, At, B0); PG8_BAR; PG8_SCHED;
            PG8_STAGE(PG8_SB(1, 1), b3 + hstep, voffB);
            PG8_WAIT_V(6); PG8_BAR; PG8_MMA(1, 1, At, B1); PG8_BAR;
            }
            if constexpr (Epi::HAS_MID) { if (t + 2 == (nt >> 1)) E.mid(acc, cur, wr, wc, fr, fq); }
        }
        if constexpr (ALIGN_EPI) { if (wr == 0) PG8_BAR; }
        if constexpr (!Epi::AFTER_DRAIN) { E(acc, cur, wr, wc, fr, fq); S.done(cur); }
        if (!has_next) break;
#pragma unroll
        for (int a = 0; a < 2; ++a)
#pragma unroll
            for (int b = 0; b < 2; ++b)
#pragma unroll
                for (int m = 0; m < 4; ++m)
#pragma unroll
                    for (int n = 0; n < 2; ++n) acc[a][b][m][n] = (f32x4){0.f, 0.f, 0.f, 0.f};
        cur = nxt; cA = nA; cB = nB; ++ui;
        if constexpr (ALIGN_EPI) { if (wr == 1) PG8_BAR; }
    }
    PG8_WAIT_V(0);
    if constexpr (!ALIGN_EPI) { if (wr == 0) PG8_BAR; }
    PG8_BAR;
    if constexpr (Epi::AFTER_DRAIN) { E.fused(acc, cur, wr, wc, fr, fq, lds, wid, lane); S.done(cur); }
#undef PG8_SA
#undef PG8_SB
#undef PG8_STAGE
#undef PG8_LDA
#undef PG8_LDB
#undef PG8_MMA
#undef PG8_WAIT_V
#undef PG8_WAIT_L
#undef PG8_BAR
#undef PG8_SCHED
}
}

namespace att {
using bf16 = unsigned short;
typedef short bf16x8 __attribute__((ext_vector_type(8)));
typedef short s16x4 __attribute__((ext_vector_type(4)));
typedef float f32x16 __attribute__((ext_vector_type(16)));
typedef float f32x4 __attribute__((ext_vector_type(4)));
typedef unsigned u32x4 __attribute__((ext_vector_type(4)));
constexpr int D = 128, KVBLK = 64, SHM_V = KVBLK * D * 2, SHM_K = KVBLK * D * 2;
constexpr int OFF_V = 0, OFF_K = 2 * SHM_V, OFF_WS = OFF_K + 2 * SHM_K, OFF_FL = OFF_WS + 8 * 64 * 4, OFF_XCH = OFF_FL + 2 * 64 * 4, LDS_NEED = OFF_XCH + 4 * 64 * 64 * 4;
constexpr float THR2 = 8.0f * LOG2E;
#define KSWZ(row, colB) ((row) * 256 + ((colB) ^ (((row) & 7) << 4)))
#define SBAR() __builtin_amdgcn_sched_barrier(0)
__device__ __forceinline__ int v_st(int k, int c) { const int kk = (k & ~0xC) | ((k & 4) << 1) | ((k & 8) >> 1); return ((kk >> 3) * 4 + (c >> 5)) * 512 + ((kk & 7) * 32 + (c & 31)) * 2; }
__device__ __forceinline__ int v_rd_base(int lane) { return ((lane & 3) << 3) | (((lane >> 2) & 3) << 6) | (((lane >> 4) & 1) << 5) | (((lane >> 5) & 1) << 8); }
constexpr int v_rd_off(int d0, int ks, int half) { return d0 * 512 + ks * 4096 + half * 2048; }
__device__ __forceinline__ int crow(int r, int hi) { return (r & 3) + 8 * (r >> 2) + 4 * hi; }
__device__ __forceinline__ unsigned cvtpk(float lo, float hi) { unsigned r; asm volatile("v_cvt_pk_bf16_f32 %0, %1, %2" : "=v"(r) : "v"(lo), "v"(hi)); return r; }
__device__ __forceinline__ bf16x8 load8(const bf16* p) { return *reinterpret_cast<const bf16x8*>(p); }
__device__ __forceinline__ void mask_tile(f32x16& p0, f32x16& p1, int dq) {
    const float NEG = -__builtin_inff();
#pragma unroll
    for (int r = 0; r < 16; ++r) { const int c = (r & 3) + 8 * (r >> 2); if (dq - c < 0) p0[r] = NEG; if (dq - c - 32 < 0) p1[r] = NEG; }
}
__device__ __forceinline__ void partialSM(f32x16& p0, f32x16& p1, float& m_reg, float& alpha) { float mn;
    float pmax = p0[0];
#pragma unroll
    for (int r = 1; r < 16; ++r) pmax = fmaxf(pmax, p0[r]);
#pragma unroll
    for (int r = 0; r < 16; ++r) pmax = fmaxf(pmax, p1[r]);
    { auto rr = __builtin_amdgcn_permlane32_swap(__float_as_uint(pmax), __float_as_uint(pmax), false, false);
      pmax = fmaxf(__uint_as_float(rr[0]), __uint_as_float(rr[1])); }
    if (__builtin_expect(__all((pmax - m_reg) <= THR2), 1)) { mn = m_reg; alpha = 1.f; }
    else { mn = fmaxf(m_reg, pmax); alpha = __builtin_amdgcn_exp2f(m_reg - mn); m_reg = mn; }
#pragma unroll
    for (int r = 0; r < 16; ++r) p0[r] = p0[r] - mn;
#pragma unroll
    for (int r = 0; r < 16; ++r) p1[r] = p1[r] - mn;
#pragma unroll
    for (int r = 0; r < 16; ++r) p0[r] = __builtin_amdgcn_exp2f(p0[r]);
}
__device__ __forceinline__ void finishSM(f32x16& p0, f32x16& p1, float alpha, float& l_reg, bf16x8& pa0, bf16x8& pa1, bf16x8& pa2, bf16x8& pa3) {
#pragma unroll
    for (int r = 0; r < 16; ++r) p1[r] = __builtin_amdgcn_exp2f(p1[r]);
    float ps = 0;
#pragma unroll
    for (int r = 0; r < 16; ++r) ps += p0[r];
#pragma unroll
    for (int r = 0; r < 16; ++r) ps += p1[r];
    { auto rr = __builtin_amdgcn_permlane32_swap(__float_as_uint(ps), __float_as_uint(ps), false, false);
      ps = __uint_as_float(rr[0]) + __uint_as_float(rr[1]); }
    l_reg = l_reg * alpha + ps;
#define PK4(P, B_, OUT) do { unsigned a0 = cvtpk(P[B_+0], P[B_+1]), a1 = cvtpk(P[B_+2], P[B_+3]);                          \
        unsigned b0 = cvtpk(P[B_+4], P[B_+5]), b1 = cvtpk(P[B_+6], P[B_+7]);                                             \
        auto r0 = __builtin_amdgcn_permlane32_swap(a0, b0, false, false); auto r1 = __builtin_amdgcn_permlane32_swap(a1, b1, false, false); \
        u32x4 w = {r0[0], r1[0], r0[1], r1[1]}; OUT = *reinterpret_cast<bf16x8*>(&w); } while (0)
    PK4(p0, 0, pa0); PK4(p0, 8, pa1); PK4(p1, 0, pa2); PK4(p1, 8, pa3);
#undef PK4
}
__device__ __forceinline__ void partialSM_nb(f32x16& p0, f32x16& p1, float& m_reg, float& alpha) {
    float pmax = p0[0];
#pragma unroll
    for (int r = 1; r < 16; ++r) pmax = fmaxf(pmax, p0[r]);
#pragma unroll
    for (int r = 0; r < 16; ++r) pmax = fmaxf(pmax, p1[r]);
    { auto rr = __builtin_amdgcn_permlane32_swap(__float_as_uint(pmax), __float_as_uint(pmax), false, false);
      pmax = fmaxf(__uint_as_float(rr[0]), __uint_as_float(rr[1])); }
    const bool ok = __all((pmax - m_reg) <= THR2);
    const float mn = ok ? m_reg : fmaxf(m_reg, pmax);
    alpha = __builtin_amdgcn_exp2f(m_reg - mn); m_reg = mn;
#pragma unroll
    for (int r = 0; r < 16; ++r) p0[r] = p0[r] - mn;
#pragma unroll
    for (int r = 0; r < 16; ++r) p1[r] = p1[r] - mn;
#pragma unroll
    for (int r = 0; r < 16; ++r) p0[r] = __builtin_amdgcn_exp2f(p0[r]);
}
__device__ __forceinline__ void finishSM_t(f32x16& p0, f32x16& p1, float alpha, float& l_reg, bf16x8& pa0, bf16x8& pa1, bf16x8& pa2, bf16x8& pa3) {
#pragma unroll
    for (int r = 0; r < 16; ++r) p1[r] = __builtin_amdgcn_exp2f(p1[r]);
    float s0 = p0[0] + p0[1], s1 = p0[2] + p0[3], s2 = p0[4] + p0[5], s3 = p0[6] + p0[7];
    s0 += p0[8]; s1 += p0[9]; s2 += p0[10]; s3 += p0[11]; s0 += p0[12]; s1 += p0[13]; s2 += p0[14]; s3 += p0[15];
#pragma unroll
    for (int r = 0; r < 16; r += 4) { s0 += p1[r]; s1 += p1[r + 1]; s2 += p1[r + 2]; s3 += p1[r + 3]; }
    float ps = (s0 + s1) + (s2 + s3);
    { auto rr = __builtin_amdgcn_permlane32_swap(__float_as_uint(ps), __float_as_uint(ps), false, false);
      ps = __uint_as_float(rr[0]) + __uint_as_float(rr[1]); }
    l_reg = l_reg * alpha + ps;
#define PK4(P, B_, OUT) do { unsigned a0 = cvtpk(P[B_+0], P[B_+1]), a1 = cvtpk(P[B_+2], P[B_+3]);                          \
        unsigned b0 = cvtpk(P[B_+4], P[B_+5]), b1 = cvtpk(P[B_+6], P[B_+7]);                                             \
        auto r0 = __builtin_amdgcn_permlane32_swap(a0, b0, false, false); auto r1 = __builtin_amdgcn_permlane32_swap(a1, b1, false, false); \
        u32x4 w = {r0[0], r1[0], r0[1], r1[1]}; OUT = *reinterpret_cast<bf16x8*>(&w); } while (0)
    PK4(p0, 0, pa0); PK4(p0, 8, pa1); PK4(p1, 0, pa2); PK4(p1, 8, pa3);
#undef PK4
}
template <int KB, int MODE>
__device__ __forceinline__ void qkt_fast(f32x16& p0, f32x16& p1, const char* K_lds, const float* Fl, int r32, int hi, const bf16x8* qr, const char* ql, int khalf) {
    if constexpr (MODE == 1) { const float* gb = Fl + KB * 64 + 4 * hi;
#pragma unroll
        for (int g = 0; g < 4; ++g) { const f32x4 a = *(const f32x4*)(gb + 8 * g), b = *(const f32x4*)(gb + 32 + 8 * g);
            p0[4 * g] = a[0]; p0[4 * g + 1] = a[1]; p0[4 * g + 2] = a[2]; p0[4 * g + 3] = a[3];
            p1[4 * g] = b[0]; p1[4 * g + 1] = b[1]; p1[4 * g + 2] = b[2]; p1[4 * g + 3] = b[3]; } }
    else { p0 = f32x16{}; p1 = f32x16{}; }
    const char* kb[4];
#pragma unroll
    for (int dd = 0; dd < 4; ++dd) kb[dd] = K_lds + KB * SHM_K + KSWZ(r32, (dd * 16 + hi * 8) * 2);
    if constexpr (MODE == 1) {
#pragma unroll
        for (int d0 = 0; d0 < 8; ++d0) { const char* a = kb[d0 & 3] + (d0 >> 2) * 128;
            bf16x8 b0 = *reinterpret_cast<const bf16x8*>(a);
            bf16x8 b1 = *reinterpret_cast<const bf16x8*>(a + 32 * 256);
            const bf16x8 q = *reinterpret_cast<const bf16x8*>(ql + d0 * 1024);
            p0 = __builtin_amdgcn_mfma_f32_32x32x16_bf16(b0, q, p0, 0, 0, 0);
            p1 = __builtin_amdgcn_mfma_f32_32x32x16_bf16(b1, q, p1, 0, 0, 0); }
    } else {
#pragma unroll
        for (int d0 = 0; d0 < 4; ++d0) { const char* a = kb[d0] + khalf * 128;
            bf16x8 b0 = *reinterpret_cast<const bf16x8*>(a);
            bf16x8 b1 = *reinterpret_cast<const bf16x8*>(a + 32 * 256);
            p0 = __builtin_amdgcn_mfma_f32_32x32x16_bf16(b0, qr[d0], p0, 0, 0, 0);
            p1 = __builtin_amdgcn_mfma_f32_32x32x16_bf16(b1, qr[d0], p1, 0, 0, 0); }
    }
}
typedef short v4i16_t __attribute__((ext_vector_type(4)));
typedef __attribute__((address_space(3))) const char* lds_cptr;
__device__ __forceinline__ s16x4 vtr(lds_cptr p) { return __builtin_bit_cast(s16x4, __builtin_amdgcn_ds_read_tr16_b64_v4i16((__attribute__((address_space(3))) v4i16_t*)p)); }
template <int VB>
__device__ __forceinline__ void pv_fast(f32x16* o, lds_cptr vp, bf16x8 pa0, bf16x8 pa1, bf16x8 pa2, bf16x8 pa3) {
#pragma unroll
    for (int d0 = 0; d0 < 4; ++d0) {
        constexpr int base = OFF_V + VB * SHM_V;
        const s16x4 l0 = vtr(vp + base + d0 * 512), h0 = vtr(vp + base + d0 * 512 + 2048), l1 = vtr(vp + base + d0 * 512 + 4096), h1 = vtr(vp + base + d0 * 512 + 6144);
        const s16x4 l2 = vtr(vp + base + d0 * 512 + 8192), h2 = vtr(vp + base + d0 * 512 + 10240), l3 = vtr(vp + base + d0 * 512 + 12288), h3 = vtr(vp + base + d0 * 512 + 14336);
        o[d0] = __builtin_amdgcn_mfma_f32_32x32x16_bf16(pa0, (bf16x8){l0[0], l0[1], l0[2], l0[3], h0[0], h0[1], h0[2], h0[3]}, o[d0], 0, 0, 0);
        o[d0] = __builtin_amdgcn_mfma_f32_32x32x16_bf16(pa1, (bf16x8){l1[0], l1[1], l1[2], l1[3], h1[0], h1[1], h1[2], h1[3]}, o[d0], 0, 0, 0);
        o[d0] = __builtin_amdgcn_mfma_f32_32x32x16_bf16(pa2, (bf16x8){l2[0], l2[1], l2[2], l2[3], h2[0], h2[1], h2[2], h2[3]}, o[d0], 0, 0, 0);
        o[d0] = __builtin_amdgcn_mfma_f32_32x32x16_bf16(pa3, (bf16x8){l3[0], l3[1], l3[2], l3[3], h3[0], h3[1], h3[2], h3[3]}, o[d0], 0, 0, 0);
    }
}
template <int KB, int MODE>
__device__ __forceinline__ void qkt(f32x16& p0, f32x16& p1, const char* K_lds, const float* Fl, int r32, int hi, const bf16x8* qr, const char* ql, bool act, int khalf) {
    if (!act) { const float NEG = -__builtin_inff();
#pragma unroll
        for (int r = 0; r < 16; ++r) { p0[r] = NEG; p1[r] = NEG; } return; }
    if constexpr (MODE == 1) { const float* gb = Fl + KB * 64 + 4 * hi;
#pragma unroll
        for (int g = 0; g < 4; ++g) { const f32x4 a = *(const f32x4*)(gb + 8 * g), b = *(const f32x4*)(gb + 32 + 8 * g);
            p0[4 * g] = a[0]; p0[4 * g + 1] = a[1]; p0[4 * g + 2] = a[2]; p0[4 * g + 3] = a[3];
            p1[4 * g] = b[0]; p1[4 * g + 1] = b[1]; p1[4 * g + 2] = b[2]; p1[4 * g + 3] = b[3]; } }
    else { p0 = f32x16{}; p1 = f32x16{}; }
    const char* kb[4];
#pragma unroll
    for (int dd = 0; dd < 4; ++dd) kb[dd] = K_lds + KB * SHM_K + KSWZ(r32, (dd * 16 + hi * 8) * 2);
    if constexpr (MODE == 1) {
#pragma unroll
        for (int d0 = 0; d0 < 8; ++d0) { const char* a = kb[d0 & 3] + (d0 >> 2) * 128;
            bf16x8 b0 = *reinterpret_cast<const bf16x8*>(a);
            bf16x8 b1 = *reinterpret_cast<const bf16x8*>(a + 32 * 256);
            const bf16x8 q = *reinterpret_cast<const bf16x8*>(ql + d0 * 1024);
            p0 = __builtin_amdgcn_mfma_f32_32x32x16_bf16(b0, q, p0, 0, 0, 0);
            p1 = __builtin_amdgcn_mfma_f32_32x32x16_bf16(b1, q, p1, 0, 0, 0);
            if (d0 == 3) SBAR(); }
    } else {
#pragma unroll
        for (int d0 = 0; d0 < 4; ++d0) { const char* a = kb[d0] + khalf * 128;
            bf16x8 b0 = *reinterpret_cast<const bf16x8*>(a);
            bf16x8 b1 = *reinterpret_cast<const bf16x8*>(a + 32 * 256);
            p0 = __builtin_amdgcn_mfma_f32_32x32x16_bf16(b0, qr[d0], p0, 0, 0, 0);
            p1 = __builtin_amdgcn_mfma_f32_32x32x16_bf16(b1, qr[d0], p1, 0, 0, 0); }
    }
}
template <int VB>
__device__ __forceinline__ void pv_tile(f32x16* o, int vb0, bf16x8 pa0, bf16x8 pa1, bf16x8 pa2, bf16x8 pa3, bool act) {
    if (!act) return;
#define TRRD(dst, off) asm volatile("ds_read_b64_tr_b16 %0, %1 offset:%2" : "=&v"(dst) : "v"(vb0), "i"(off) : "memory")
#define PV_D0(d0) do { s16x4 l0, l1, l2, l3, h0, h1, h2, h3; constexpr int b_ = OFF_V + VB * SHM_V + v_rd_off(d0, 0, 0);   \
        TRRD(l0, b_); TRRD(h0, b_ + 2048); TRRD(l1, b_ + 4096); TRRD(h1, b_ + 6144); TRRD(l2, b_ + 8192); TRRD(h2, b_ + 10240); TRRD(l3, b_ + 12288); TRRD(h3, b_ + 14336); \
        asm volatile("s_waitcnt lgkmcnt(0)" ::: "memory"); SBAR();   \
        o[d0] = __builtin_amdgcn_mfma_f32_32x32x16_bf16(pa0, (bf16x8){l0[0], l0[1], l0[2], l0[3], h0[0], h0[1], h0[2], h0[3]}, o[d0], 0, 0, 0);   \
        o[d0] = __builtin_amdgcn_mfma_f32_32x32x16_bf16(pa1, (bf16x8){l1[0], l1[1], l1[2], l1[3], h1[0], h1[1], h1[2], h1[3]}, o[d0], 0, 0, 0);   \
        o[d0] = __builtin_amdgcn_mfma_f32_32x32x16_bf16(pa2, (bf16x8){l2[0], l2[1], l2[2], l2[3], h2[0], h2[1], h2[2], h2[3]}, o[d0], 0, 0, 0);   \
        o[d0] = __builtin_amdgcn_mfma_f32_32x32x16_bf16(pa3, (bf16x8){l3[0], l3[1], l3[2], l3[3], h3[0], h3[1], h3[2], h3[3]}, o[d0], 0, 0, 0); } while (0)
    PV_D0(0); PV_D0(1); PV_D0(2); PV_D0(3);
#undef PV_D0
#undef TRRD
}
struct BlockRef { const bf16* Q; const bf16* K; const bf16* V; bf16* O; const float* F; int P0; };
struct Seam { bf16x8 qr[8]; bf16x8 st_v0, st_v1, st_k0, st_k1; float st_f; };
__device__ __forceinline__ float ld_agent(const float* p) { return __uint_as_float((unsigned)__builtin_amdgcn_readfirstlane((int)__float_as_uint(__hip_atomic_load(p, __ATOMIC_RELAXED, __HIP_MEMORY_SCOPE_AGENT)))); }
__device__ __forceinline__ int fox_nt(const float* F, int P0, float bnd_nat) {
    int lane = threadIdx.x & 63; asm volatile("" : "+v"(lane));
    const int jl = (P0 + 255) >> 6;
    const float thresh = ld_agent(F + P0) + bnd_nat;
    int n = 0;
    for (int base = 0; base <= jl; base += 64) {
        const int j = jl - base - lane; bool need = false;
        if (j >= 0) need = __hip_atomic_load(F + 64 * j + 63, __ATOMIC_RELAXED, __HIP_MEMORY_SCOPE_AGENT) <= thresh;
        const int c = __popcll(__ballot(need)); n += c; if (c < 64) break;
    }
    n = n < 4 ? 4 : n; n = n > jl + 1 ? jl + 1 : n;
    return __builtin_amdgcn_readfirstlane(n);
}
#define ROW(p, k0, rr) ((p) + (size_t)((k0) + (rr)) * D + sc)
#define BAR() do { asm volatile("s_waitcnt lgkmcnt(0)" ::: "memory"); __builtin_amdgcn_s_barrier(); asm volatile("" ::: "memory"); } while (0)
#define SLOAD_K(Kp, Fp, k0) do { S.st_k0 = load8(ROW(Kp, k0, sr)); S.st_k1 = load8(ROW(Kp, k0, 32 + sr)); if (MODE == 1 && wid == 0) S.st_f = (Fp)[(k0) + lane]; } while (0)
#define SLOAD_V(Vp, k0) do { S.st_v0 = load8(ROW(Vp, k0, sr)); S.st_v1 = load8(ROW(Vp, k0, 32 + sr)); } while (0)
#define SWRITE_K(bf, fr_) do { *(bf16x8*)(K_lds + (bf) * SHM_K + kws) = S.st_k0; *(bf16x8*)(K_lds + (bf) * SHM_K + kws + 32 * 256) = S.st_k1; \
                         if (MODE == 1 && wid == 0) Fl[(bf) * 64 + lane] = ((fr_) - S.st_f) * LOG2E; } while (0)
#define SWRITE_V(bf) do { *(bf16x8*)(V_lds + (bf) * SHM_V + vst0) = S.st_v0; *(bf16x8*)(V_lds + (bf) * SHM_V + vst1) = S.st_v1; } while (0)
template <int MODE>
__device__ __forceinline__ void attn_prime(const BlockRef& cur, char* lds, Seam& S) {
    constexpr int QROWS = MODE == 0 ? 128 : 256;
    int tid = threadIdx.x; asm volatile("" : "+v"(tid));
    const int wid = __builtin_amdgcn_readfirstlane(tid >> 6), lane = tid & 63, r32 = lane & 31, hi = lane >> 5;
    const int sr = tid >> 4, sc = (tid & 15) * 8, kws = KSWZ(sr, sc * 2); char* K_lds = lds + OFF_K; float* Fl = (float*)(lds + OFF_FL);
    const int kb0 = ((cur.P0 + QROWS - 1) / KVBLK) * KVBLK;
    if constexpr (MODE == 0) {
#pragma unroll
        for (int d0 = 0; d0 < 4; ++d0) S.qr[d0] = load8(cur.Q + (size_t)((wid & 3) * 32 + r32) * D + (wid >> 2) * 64 + d0 * 16 + hi * 8);
    } else {
#pragma unroll
        for (int d0 = 0; d0 < 8; ++d0) S.qr[d0] = load8(cur.Q + (size_t)(wid * 32 + r32) * D + d0 * 16 + hi * 8);
    }
    float fref = 0.f; if constexpr (MODE == 1) fref = ld_agent(cur.F + cur.P0);
    SLOAD_K(cur.K, cur.F, kb0); SLOAD_V(cur.V, kb0); SBAR(); SWRITE_K(0, fref); SBAR(); SLOAD_K(cur.K, cur.F, kb0 - KVBLK);
    __syncthreads();
}
template <int MODE>
__device__ __forceinline__ void attn_block(const BlockRef& cur, const BlockRef& nxt, const int NT, float lam, const float* gsub, char* lds, Seam& S, const bool dry = false) {
    constexpr int QROWS = MODE == 0 ? 128 : 256;
    int tid = threadIdx.x; asm volatile("" : "+v"(tid));
    const int wid = __builtin_amdgcn_readfirstlane(tid >> 6), lane = tid & 63, r32 = lane & 31, hi = lane >> 5;
    const bool lag = wid >= 4;
    const int jl = (cur.P0 + QROWS - 1) / KVBLK;
    const int kbn = ((nxt.P0 + QROWS - 1) / KVBLK) * KVBLK;
    const int wrow = MODE == 0 ? (wid & 3) * 32 : wid * 32, khalf = MODE == 0 ? (wid >> 2) : 0;
    const int qlo = cur.P0 + wrow, qm = qlo + r32 - 4 * hi;
    char* V_lds = lds + OFF_V; char* K_lds = lds + OFF_K;
    float* ws = (float*)(lds + OFF_WS) + wid * 64; float* li_l = ws, * al_l = ws + 32; float* Fl = (float*)(lds + OFF_FL);
    float m_reg = -1e30f, l_reg = 0; f32x16 o[4] = {};
    const int sr = tid >> 4, sc = (tid & 15) * 8, vst0 = v_st(sr, sc), vst1 = v_st(32 + sr, sc), kws = KSWZ(sr, sc * 2);
    const int vb0 = (int)(uintptr_t)lds + v_rd_base(lane);
    const bf16* Kh = cur.K; const bf16* Vh = cur.V; const float* Fh = cur.F;
    float fref = 0.f, frefn = 0.f;
    if constexpr (MODE == 1) { fref = ld_agent(cur.F + cur.P0); frefn = ld_agent(nxt.F + nxt.P0); }
#define RESC(a) do { if (__any((a) < 1.f)) { if (hi == 0) al_l[r32] = (a); asm volatile("s_waitcnt lgkmcnt(0)" ::: "memory");              \
                     for (int d_ = 0; d_ < 4; ++d_) for (int r = 0; r < 16; ++r) o[d_][r] *= al_l[crow(r, hi)]; } } while (0)
#define KBASE(t) ((jl - (t)) * KVBLK)
#define ACT(t) (KBASE(t) <= qlo + (MODE == 0 ? 0 : 31))
#define MASKT(P0_, P1_, t) do { if constexpr (MODE == 1) { const int kb_ = KBASE(t); if (ACT(t) && kb_ + KVBLK - 1 > qlo) mask_tile(P0_, P1_, qm - kb_); } } while (0)
    f32x16 pA0, pA1, pB0, pB1; float alA = 1.f, alB = 1.f; bf16x8 pa0, pa1, pa2, pa3;
    const char* ql = lds + OFF_XCH + wid * 8192 + lane * 16;
    if constexpr (MODE == 1) {
#pragma unroll
        for (int d0 = 0; d0 < 8; ++d0) *(bf16x8*)(lds + OFF_XCH + wid * 8192 + d0 * 1024 + lane * 16) = S.qr[d0];
    }
    if (lag) BAR();
#define STEP_A(t, PX0, PX1, PY0, PY1, alY, KB) do {                                                                          \
        SBAR();                                                                                                               \
        if ((t) < NT) qkt<KB, MODE>(PX0, PX1, K_lds, Fl, r32, hi, S.qr, ql, ACT(t), khalf);                                   \
        if ((t) >= 1 && (t) <= NT) finishSM(PY0, PY1, alY, l_reg, pa0, pa1, pa2, pa3);                                        \
        SBAR();                                                                                                               \
        if ((t) + 1 < NT) { SWRITE_K((KB) ^ 1, fref); SBAR();                                                                 \
            if ((t) + 2 < NT) SLOAD_K(Kh, Fh, KBASE((t) + 2)); else SLOAD_K(nxt.K, nxt.F, kbn); }                             \
        BAR(); } while (0)
#define STEP_B(t, PX0, PX1, alX, VBP, VBC) do {                                                                         \
        SBAR();                                                                                                               \
        if ((t) >= 1 && (t) <= NT) pv_tile<VBP>(o, vb0, pa0, pa1, pa2, pa3, ACT((t) - 1));                                    \
        if ((t) < NT) { MASKT(PX0, PX1, (t)); partialSM(PX0, PX1, m_reg, alX); RESC(alX); SBAR();                        \
            SWRITE_V(VBC); SBAR();                                                                                            \
            if ((t) + 1 < NT) SLOAD_V(Vh, KBASE((t) + 1)); else SLOAD_V(nxt.V, kbn); }                                        \
        BAR(); } while (0)
#define VRD(dst, VB_, hg_) do { constexpr int b_ = OFF_V + (VB_) * SHM_V + ((hg_) >> 1) * 512 + ((hg_) & 1) * 8192;     \
        dst[0] = vtr(vp3 + b_); dst[1] = vtr(vp3 + b_ + 2048); dst[2] = vtr(vp3 + b_ + 4096); dst[3] = vtr(vp3 + b_ + 6144); } while (0)
#define VFRG(v, i) (bf16x8){v[2*(i)][0], v[2*(i)][1], v[2*(i)][2], v[2*(i)][3], v[2*(i)+1][0], v[2*(i)+1][1], v[2*(i)+1][2], v[2*(i)+1][3]}
#define PVMM(v, hg_) do { if (((hg_) & 1) == 0) { o[(hg_) >> 1] = __builtin_amdgcn_mfma_f32_32x32x16_bf16(pa0, VFRG(v, 0), o[(hg_) >> 1], 0, 0, 0); o[(hg_) >> 1] = __builtin_amdgcn_mfma_f32_32x32x16_bf16(pa1, VFRG(v, 1), o[(hg_) >> 1], 0, 0, 0); } \
        else { o[(hg_) >> 1] = __builtin_amdgcn_mfma_f32_32x32x16_bf16(pa2, VFRG(v, 0), o[(hg_) >> 1], 0, 0, 0); o[(hg_) >> 1] = __builtin_amdgcn_mfma_f32_32x32x16_bf16(pa3, VFRG(v, 1), o[(hg_) >> 1], 0, 0, 0); } } while (0)
#define FSTEP_B(t, PX0, PX1, alX, VBP, VBC) do {                                                                             \
        SBAR(); s16x4 va_[4], vb_[4];                                                                                         \
        VRD(va_, VBP, 0); SBAR();                                                                                             \
        VRD(vb_, VBP, 1); PVMM(va_, 0);                                                                                       \
        float m0_ = fmaxf(fmaxf(PX0[0], PX0[1]), PX0[2]), m1_ = fmaxf(fmaxf(PX0[3], PX0[4]), PX0[5]), m2_ = fmaxf(fmaxf(PX0[6], PX0[7]), PX0[8]), m3_ = fmaxf(fmaxf(PX0[9], PX0[10]), PX0[11]); \
        SBAR();                                                                                                               \
        VRD(va_, VBP, 2); PVMM(vb_, 1);                                                                                       \
        m0_ = fmaxf(fmaxf(m0_, PX0[12]), PX0[13]); m1_ = fmaxf(fmaxf(m1_, PX0[14]), PX0[15]); m2_ = fmaxf(fmaxf(m2_, PX1[0]), PX1[1]); m3_ = fmaxf(fmaxf(m3_, PX1[2]), PX1[3]); \
        SBAR();                                                                                                               \
        VRD(vb_, VBP, 3); PVMM(va_, 2);                                                                                       \
        m0_ = fmaxf(fmaxf(m0_, PX1[4]), PX1[5]); m1_ = fmaxf(fmaxf(m1_, PX1[6]), PX1[7]); m2_ = fmaxf(fmaxf(m2_, PX1[8]), PX1[9]); m3_ = fmaxf(fmaxf(m3_, PX1[10]), PX1[11]); \
        m0_ = fmaxf(fmaxf(m0_, PX1[12]), PX1[13]); m1_ = fmaxf(fmaxf(m1_, PX1[14]), PX1[15]);                                 \
        SBAR();                                                                                                               \
        VRD(va_, VBP, 4); PVMM(vb_, 3);                                                                                       \
        float pmax_ = fmaxf(fmaxf(m0_, m1_), fmaxf(m2_, m3_));                                                                \
        { auto rr_ = __builtin_amdgcn_permlane32_swap(__float_as_uint(pmax_), __float_as_uint(pmax_), false, false); pmax_ = fmaxf(__uint_as_float(rr_[0]), __uint_as_float(rr_[1])); } \
        const bool ok_ = __all((pmax_ - m_reg) <= THR2); const float mn_ = ok_ ? m_reg : fmaxf(m_reg, pmax_);                  \
        alX = __builtin_amdgcn_exp2f(m_reg - mn_); m_reg = mn_;                                                               \
        SBAR();                                                                                                               \
        VRD(vb_, VBP, 5); PVMM(va_, 4);                                                                                       \
        _Pragma("unroll") for (int r = 0; r < 16; ++r) PX0[r] = PX0[r] - mn_;                                                 \
        SBAR();                                                                                                               \
        VRD(va_, VBP, 6); PVMM(vb_, 5);                                                                                       \
        _Pragma("unroll") for (int r = 0; r < 16; ++r) PX1[r] = PX1[r] - mn_;                                                 \
        _Pragma("unroll") for (int r = 0; r < 4; ++r) PX0[r] = __builtin_amdgcn_exp2f(PX0[r]);                                \
        SBAR();                                                                                                               \
        VRD(vb_, VBP, 7); PVMM(va_, 6);                                                                                       \
        _Pragma("unroll") for (int r = 4; r < 10; ++r) PX0[r] = __builtin_amdgcn_exp2f(PX0[r]);                               \
        SBAR();                                                                                                               \
        PVMM(vb_, 7);                                                                                                         \
        _Pragma("unroll") for (int r = 10; r < 16; ++r) PX0[r] = __builtin_amdgcn_exp2f(PX0[r]);                              \
        SBAR();                                                                                                               \
        RESC(alX); SBAR();                                                                                                    \
        SWRITE_V(VBC); SBAR(); SLOAD_V(Vh, KBASE((t) + 1));                                                                   \
        BAR(); } while (0)
#define KRD(dst, KB_, d0_) do { const char* a_ = K_lds + (KB_) * SHM_K + khalf * 128 + KSWZ(r32, ((d0_) * 16 + hi * 8) * 2); dst[0] = *reinterpret_cast<const bf16x8*>(a_); dst[1] = *reinterpret_cast<const bf16x8*>(a_ + 32 * 256); } while (0)
#define QKMM(PX0, PX1, kf_, i) do { PX0 = __builtin_amdgcn_mfma_f32_32x32x16_bf16(kf_[0], S.qr[i], PX0, 0, 0, 0); PX1 = __builtin_amdgcn_mfma_f32_32x32x16_bf16(kf_[1], S.qr[i], PX1, 0, 0, 0); } while (0)
#define FSTEP_A(t, PX0, PX1, PY0, PY1, alY, KB) do {                                                                         \
        SBAR(); bf16x8 ka_[2];                                                                                                \
        KRD(ka_, KB, 0); PX0 = f32x16{}; PX1 = f32x16{};                                                                      \
        _Pragma("unroll") for (int r = 0; r < 8; ++r) PY1[r] = __builtin_amdgcn_exp2f(PY1[r]);                                \
        SBAR();                                                                                                               \
        QKMM(PX0, PX1, ka_, 0); KRD(ka_, KB, 1);                                                                              \
        _Pragma("unroll") for (int r = 8; r < 16; ++r) PY1[r] = __builtin_amdgcn_exp2f(PY1[r]);                               \
        SBAR();                                                                                                               \
        QKMM(PX0, PX1, ka_, 1); KRD(ka_, KB, 2);                                                                              \
        float s0_ = PY0[0] + PY0[1], s1_ = PY0[2] + PY0[3], s2_ = PY0[4] + PY0[5], s3_ = PY0[6] + PY0[7];                       \
        s0_ += PY0[8]; s1_ += PY0[9]; s2_ += PY0[10]; s3_ += PY0[11]; s0_ += PY0[12]; s1_ += PY0[13]; s2_ += PY0[14]; s3_ += PY0[15]; \
        _Pragma("unroll") for (int r = 0; r < 16; r += 4) { s0_ += PY1[r]; s1_ += PY1[r + 1]; s2_ += PY1[r + 2]; s3_ += PY1[r + 3]; } \
        float ps_ = (s0_ + s1_) + (s2_ + s3_);                                                                                \
        { auto rr_ = __builtin_amdgcn_permlane32_swap(__float_as_uint(ps_), __float_as_uint(ps_), false, false); ps_ = __uint_as_float(rr_[0]) + __uint_as_float(rr_[1]); } \
        l_reg = l_reg * alY + ps_;                                                                                            \
        SBAR();                                                                                                               \
        QKMM(PX0, PX1, ka_, 2); KRD(ka_, KB, 3);                                                                              \
        PK4_(PY0, 0, pa0); PK4_(PY0, 8, pa1);                                                                                 \
        SBAR();                                                                                                               \
        QKMM(PX0, PX1, ka_, 3);                                                                                               \
        PK4_(PY1, 0, pa2); PK4_(PY1, 8, pa3);                                                                                 \
        SBAR();                                                                                                               \
        SWRITE_K((KB) ^ 1, fref); SBAR(); SLOAD_K(Kh, Fh, KBASE((t) + 2));                                                    \
        BAR(); } while (0)
#define PK4_(P, B_, OUT) do { unsigned a0 = cvtpk(P[B_+0], P[B_+1]), a1 = cvtpk(P[B_+2], P[B_+3]);                          \
        unsigned b0 = cvtpk(P[B_+4], P[B_+5]), b1 = cvtpk(P[B_+6], P[B_+7]);                                             \
        auto r0 = __builtin_amdgcn_permlane32_swap(a0, b0, false, false); auto r1 = __builtin_amdgcn_permlane32_swap(a1, b1, false, false); \
        u32x4 w = {r0[0], r1[0], r0[1], r1[1]}; OUT = *reinterpret_cast<bf16x8*>(&w); } while (0)
    constexpr int T0 = 2;
    const lds_cptr vp3 = (lds_cptr)(__attribute__((address_space(3))) const char*)lds + v_rd_base(lane);
    int t0 = 0;
    if constexpr (MODE == 0) {
        for (; t0 < T0; t0 += 2) {
            STEP_A(t0, pA0, pA1, pB0, pB1, alB, 0); STEP_B(t0, pA0, pA1, alA, 1, 0);
            STEP_A(t0 + 1, pB0, pB1, pA0, pA1, alA, 1); STEP_B(t0 + 1, pB0, pB1, alB, 0, 1);
        }
        for (; t0 + 3 < NT; t0 += 2) {
            FSTEP_A(t0, pA0, pA1, pB0, pB1, alB, 0); FSTEP_B(t0, pA0, pA1, alA, 1, 0);
            FSTEP_A(t0 + 1, pB0, pB1, pA0, pA1, alA, 1); FSTEP_B(t0 + 1, pB0, pB1, alB, 0, 1);
        }
    }
    for (; t0 <= NT; t0 += 2) {
        STEP_A(t0, pA0, pA1, pB0, pB1, alB, 0); STEP_B(t0, pA0, pA1, alA, 1, 0);
        STEP_A(t0 + 1, pB0, pB1, pA0, pA1, alA, 1); STEP_B(t0 + 1, pB0, pB1, alB, 0, 1);
    }
#undef FSTEP_A
#undef FSTEP_B
#undef VRD
#undef VFRG
#undef PVMM
#undef QKMM
#undef KRD
#undef PK4_
    if constexpr (MODE == 0) {
#pragma unroll
        for (int d0 = 0; d0 < 4; ++d0) S.qr[d0] = load8(nxt.Q + (size_t)((wid & 3) * 32 + r32) * D + (wid >> 2) * 64 + d0 * 16 + hi * 8);
    } else {
#pragma unroll
        for (int d0 = 0; d0 < 8; ++d0) S.qr[d0] = load8(nxt.Q + (size_t)(wid * 32 + r32) * D + d0 * 16 + hi * 8);
    }
    SBAR();
    if (!lag) BAR();
    SWRITE_K(0, frefn); SBAR(); SLOAD_K(nxt.K, nxt.F, kbn - KVBLK); SBAR();
    if (hi == 0) li_l[r32] = l_reg; asm volatile("s_waitcnt lgkmcnt(0)" ::: "memory");
    float rli[16];
#pragma unroll
    for (int r = 0; r < 16; ++r) rli[r] = __builtin_amdgcn_rcpf(li_l[crow(r, hi)]);
    bf16* Ow = cur.O + (size_t)wrow * D;
    if constexpr (MODE == 0) {
        float* xch = (float*)(lds + OFF_XCH) + (wid & 3) * 4096 + lane;
        if (wid >= 4) {
#pragma unroll
            for (int d0 = 0; d0 < 4; ++d0)
#pragma unroll
                for (int r = 0; r < 16; ++r) xch[(d0 * 16 + r) * 64] = o[d0][r] * rli[r];
        }
        __syncthreads();
        if (wid < 4) {
            float ss[16];
#pragma unroll
            for (int r = 0; r < 16; ++r) { float a = 0.f;
#pragma unroll
                for (int d0 = 0; d0 < 4; ++d0) { const float v = o[d0][r] * rli[r] - lam * xch[(d0 * 16 + r) * 64]; o[d0][r] = v; a += v * v; }
                ss[r] = a; }
#pragma unroll
            for (int r = 0; r < 16; ++r) { float a = ss[r]; a += __shfl_xor(a, 1); a += __shfl_xor(a, 2); a += __shfl_xor(a, 4); a += __shfl_xor(a, 8); a += __shfl_xor(a, 16); ss[r] = a; }
            float g4[4];
#pragma unroll
            for (int d0 = 0; d0 < 4; ++d0) g4[d0] = gsub[d0 * 32 + r32] * 0.8f;
#pragma unroll
            for (int r = 0; r < 16; ++r) { const int orow = crow(r, hi); const float rstd = 1.0f / sqrtf(ss[r] * (1.0f / 128.0f) + 1e-5f);
#pragma unroll
                for (int d0 = 0; d0 < 4; ++d0) { const float v = o[d0][r] * rstd * g4[d0]; const float vn = __shfl_xor(v, 1);
                    if ((r32 & 1) == 0 && !dry) *(unsigned*)(Ow + (size_t)orow * D + d0 * 32 + r32) = cvtpk(v, vn); } }
        }
    } else {
#pragma unroll
        for (int r = 0; r < 16; ++r) { const int orow = crow(r, hi);
#pragma unroll
            for (int d0 = 0; d0 < 4; ++d0) { const float v = o[d0][r] * rli[r]; const float vn = __shfl_xor(v, 1);
                if ((r32 & 1) == 0 && !dry) *(unsigned*)(Ow + (size_t)orow * D + d0 * 32 + r32) = cvtpk(v, vn); } }
    }
    __syncthreads();
#undef RESC
#undef KBASE
#undef ACT
#undef MASKT
#undef STEP_A
#undef STEP_B
}
#undef ROW
#undef BAR
#undef SLOAD_K
#undef SLOAD_V
#undef SWRITE_K
#undef SWRITE_V
#undef SBAR
#undef KSWZ
}

constexpr int NWAVES = 8;
#ifndef MK_N_LAUNCHES
#define MK_N_LAUNCHES 1
#endif
constexpr int PER_PHASE = 8;
constexpr int N_LAUNCHES = MK_N_LAUNCHES;

constexpr size_t MiB = 1u << 20;
constexpr size_t WS_CTL = 0, CTL_ZERO_BYTES = 1 * MiB;
constexpr size_t WS_WQKV = 1 * MiB;
constexpr size_t WS_WG = 13 * MiB;
constexpr size_t WS_WAB = 21 * MiB;
constexpr size_t WS_WO = 25 * MiB;
constexpr size_t WS_COS = 27 * MiB, WS_SIN = 29 * MiB;
constexpr size_t WS_LOGF = 31 * MiB;
constexpr size_t WS_CUMF = 31 * MiB + 512 * 1024;
constexpr size_t WS_MODP = 32 * MiB;
constexpr size_t WS_GATE = 32 * MiB + 512 * 1024;
constexpr size_t WS_PS = 33 * MiB;
constexpr size_t WS_XN = 34 * MiB;
constexpr size_t WS_QA = 66 * MiB, WS_KA = 98 * MiB, WS_VA = 130 * MiB, WS_QB = 162 * MiB, WS_X5 = 194 * MiB, WS_PN = 226 * MiB, WS_END = 230 * MiB;
constexpr size_t WS_G = WS_KA;
constexpr size_t WS_SA = WS_X5;
constexpr int CW_TMO = 0, CW_CODE = 1, CW_BAR = 4096, CW_Q = 8192;

constexpr int RING_OFF = 0, RING_BYTES = 135168;
constexpr int LDSCTL_OFF = RING_BYTES, MISC_OFF = LDSCTL_OFF + 320;
constexpr int LDS_BYTES = 147456;
static_assert(MISC_OFF + 128 <= LDS_BYTES && att::LDS_NEED <= RING_BYTES && pg8::STAGE_BYTES <= RING_BYTES, "LDS map");

#define GAS __attribute__((address_space(1)))
#define LAS __attribute__((address_space(3)))
typedef unsigned short bf16;
typedef unsigned v4u __attribute__((ext_vector_type(4)));
typedef float f32x4 __attribute__((ext_vector_type(4)));
typedef short bf16x8 __attribute__((ext_vector_type(8)));
typedef GAS unsigned gu32;
typedef GAS unsigned long long gu64;
#define RLX_AGENT __ATOMIC_RELAXED, __HIP_MEMORY_SCOPE_AGENT
#define LDS_WAIT() asm volatile("s_waitcnt lgkmcnt(0)" ::: "memory")
#define VM_WAIT() asm volatile("s_waitcnt vmcnt(0)" ::: "memory")
__device__ __forceinline__ unsigned long long rt() { return __builtin_amdgcn_s_memrealtime(); }
__device__ __forceinline__ unsigned f2bf(float f) { unsigned u = __builtin_bit_cast(unsigned, f); return (u + 0x7fffu + ((u >> 16) & 1u)) >> 16; }
__device__ __forceinline__ unsigned pk2(float lo, float hi) { return f2bf(lo) | (f2bf(hi) << 16); }

#define XB_TMO      128
#define XB_XCNT(j)  (256  + 64 * (j))
#define XB_XSUB(j)  (1280 + 64 * (j))
#define XB_XGEN(j)  (2304 + 64 * (j))
#define XB_TOP      3328
#define XB_TOPGEN   3392
#define XCD_BAR_WORDS 3456
#define XB_SPIN_CAP (1u << 18)

__device__ __forceinline__ unsigned xb_ld(unsigned* p)              { return __hip_atomic_load(p, __ATOMIC_RELAXED, __HIP_MEMORY_SCOPE_AGENT); }
__device__ __forceinline__ unsigned xb_add(unsigned* p, unsigned v) { return __hip_atomic_fetch_add(p, v, __ATOMIC_RELAXED, __HIP_MEMORY_SCOPE_AGENT); }
__device__ __forceinline__ unsigned xb_xcc_id() { return (unsigned)__builtin_amdgcn_s_getreg((3 << 11) | 20) & 0xFu; }
#define XB_SPIN(cond, bar) do { unsigned _sp = 0; while (cond) { __builtin_amdgcn_s_sleep(1); \
    if ((++_sp & 255u) == 0u) { if (xb_ld(&(bar)[XB_TMO])) break; if (_sp > XB_SPIN_CAP) { atomicAdd(&(bar)[XB_TMO], 1u); break; } } } } while (0)

struct XcdBarrier {
    unsigned* bar; unsigned x;
    volatile LAS unsigned* st;
};

__device__ __forceinline__ XcdBarrier xcd_barrier_post(unsigned* bar, volatile LAS unsigned* st) {
    XcdBarrier b; b.bar = bar; b.x = xb_xcc_id(); b.st = st;
    if (threadIdx.x == 0) (void)xb_add(&bar[XB_XCNT(b.x)], 1u);
    return b;
}
__device__ __forceinline__ void xcd_barrier_complete(unsigned* bar, unsigned x, unsigned& nloc, unsigned& nx) {
    const unsigned G = gridDim.x * gridDim.y * gridDim.z;
    unsigned sum, cnt, mine, sp = 0u;
    for (;;) {
        sum = 0u; cnt = 0u; mine = 0u;
#pragma unroll
        for (unsigned j = 0; j < 16; ++j) { const unsigned c = xb_ld(&bar[XB_XCNT(j)]); sum += c; cnt += (c > 0u) ? 1u : 0u; mine = (j == x) ? c : mine; }
        if (sum == G) break;
        __builtin_amdgcn_s_sleep(1);
        if ((++sp & 255u) == 0u) { if (xb_ld(&bar[XB_TMO])) break; if (sp > XB_SPIN_CAP) { atomicAdd(&bar[XB_TMO], 1u); break; } }
    }
    nloc = mine > 0u ? mine : 1u; nx = cnt > 0u ? cnt : 1u;
}

__device__ __forceinline__ void xcd_barrier(const XcdBarrier& b) {
    asm volatile("s_waitcnt vmcnt(0)" ::: "memory");
    __syncthreads();
    if (threadIdx.x == 0) {
        unsigned* bar = b.bar;
        __builtin_amdgcn_s_waitcnt(0);
        unsigned nloc = b.st[0], nx = b.st[1];
        if (nloc == 0u) { xcd_barrier_complete(bar, b.x, nloc, nx); b.st[0] = nloc; b.st[1] = nx; }
        const unsigned old = xb_add(&bar[XB_XSUB(b.x)], 1u);
        const unsigned gen = old / nloc;
        if (old + 1u == (gen + 1u) * nloc) {
            __builtin_amdgcn_fence(__ATOMIC_RELEASE, "agent");
            asm volatile("s_waitcnt vmcnt(0)" ::: "memory");
            const unsigned og = xb_add(&bar[XB_TOP], 1u);
            const unsigned tg = og / nx;
            if (og + 1u == (tg + 1u) * nx) xb_add(&bar[XB_TOPGEN], 1u);
            else XB_SPIN(xb_ld(&bar[XB_TOPGEN]) == tg, bar);
            __builtin_amdgcn_fence(__ATOMIC_ACQUIRE, "agent");
            xb_add(&bar[XB_XGEN(b.x)], 1u);
            asm volatile("s_waitcnt vmcnt(0)" ::: "memory");
        } else {
            XB_SPIN(xb_ld(&bar[XB_XGEN(b.x)]) == gen, bar);
            __builtin_amdgcn_fence(__ATOMIC_ACQUIRE, "agent");
            asm volatile("s_waitcnt vmcnt(0)" ::: "memory");
        }
    }
    __syncthreads();
}

struct Frame {
    LAS unsigned char* lds;
    volatile LAS unsigned* MISC;
    gu32* ctl;
    int tid, lane, wave;
    int vcu, G;
};
__device__ __forceinline__ float wave_sum(float v) {
#pragma unroll
    for (int o = 1; o < 64; o <<= 1) v += __shfl_xor(v, o);
    return v;
}
__device__ const float INV_FREQ[32] = {
    1.000000000e+00f, 7.498942018e-01f, 5.623413324e-01f, 4.216965139e-01f, 3.162277639e-01f, 2.371373773e-01f, 1.778279394e-01f, 1.333521456e-01f, 1.000000015e-01f, 7.498942316e-02f, 5.623413250e-02f, 4.216964915e-02f, 3.162277490e-02f, 2.371373773e-02f, 1.778279431e-02f, 1.333521400e-02f, 9.999999776e-03f, 7.498942316e-03f, 5.623413250e-03f, 4.216964822e-03f, 3.162277630e-03f, 2.371373819e-03f, 1.778279431e-03f, 1.333521446e-03f, 1.000000047e-03f, 7.498941850e-04f, 5.623413017e-04f, 4.216965172e-04f, 3.162277571e-04f, 2.371373703e-04f, 1.778279402e-04f, 1.333521504e-04f };
__device__ __forceinline__ void sincos_d(float angf, float& c, float& s) {
    const double a = (double)angf;
    const double k = __builtin_rint(a * 0.63661977236758134308);
    double r = __builtin_fma(-k, 1.57079632679489655800e+00, a); r = __builtin_fma(-k, 6.12323399573676603587e-17, r);
    const double r2 = r * r;
    double sp = -7.6471637318198164759e-13; sp = sp * r2 + 1.6059043836821614599e-10; sp = sp * r2 - 2.5052108385441718775e-08; sp = sp * r2 + 2.7557319223985890653e-06;
    sp = sp * r2 - 1.9841269841269841270e-04; sp = sp * r2 + 8.3333333333333333333e-03; sp = sp * r2 - 1.6666666666666666667e-01; const double sn = r + r * r2 * sp;
    double cp = 4.7794773323873852974e-14; cp = cp * r2 - 1.1470745597729724714e-11; cp = cp * r2 + 2.0876756987868098979e-09; cp = cp * r2 - 2.7557319223985890653e-07;
    cp = cp * r2 + 2.4801587301587301587e-05; cp = cp * r2 - 1.3888888888888888889e-03; cp = cp * r2 + 4.1666666666666666667e-02; cp = cp * r2 - 0.5; const double cs = 1.0 + r2 * cp;
    const int q = ((int)(long long)k) & 3;
    const double sv = (q == 0) ? sn : (q == 1) ? cs : (q == 2) ? -sn : -cs;
    const double cv = (q == 0) ? cs : (q == 1) ? -sn : (q == 2) ? -cs : sn;
    c = (float)cv; s = (float)sv;
}
__device__ __forceinline__ void p0_tr_item(const float* W, int ldw, int dst_pitch, int dst_koff, bf16* WT, int mode, LAS float* scr, int item, int nblk, int lane) {
    const int kb = item / nblk, nb = item % nblk, k0 = 64 * kb, n0 = 32 * nb;
    const int nn = n0 + (lane & 31); int sc = nn;
    if (mode == 1) { const int type = nn >> 10, j = nn & 1023, sblk = type < 3 ? type : type + 1; int jj = j;
        if (type < 2) { const int g = j >> 6, p = j & 63; jj = g * 64 + (p & 1) * 32 + (p >> 1); }
        sc = sblk * 1024 + jj; }
    else if (mode == 2) { const int type = nn >> 10, j = nn & 1023; sc = type == 0 ? 3 * 1024 + j : type == 1 ? 7 * 1024 + j : type == 2 ? 8200 + j : 9224 + j; }
#pragma unroll 8
    for (int i = 0; i < 32; ++i) { const int kk = 2 * i + (lane >> 5); scr[kk * 33 + (lane & 31)] = W[(size_t)(k0 + kk) * ldw + sc]; }
    LDS_WAIT(); asm volatile("" ::: "memory");
    const int c = lane & 7;
#pragma unroll
    for (int j = 0; j < 4; ++j) { const int n = (lane >> 3) + 8 * j; const LAS float* s = scr + (8 * c) * 33 + n;
        v4u o; o.x = pk2(s[0 * 33], s[1 * 33]); o.y = pk2(s[2 * 33], s[3 * 33]); o.z = pk2(s[4 * 33], s[5 * 33]); o.w = pk2(s[6 * 33], s[7 * 33]);
        *(GAS v4u*)(WT + (size_t)(n0 + n) * dst_pitch + dst_koff + k0 + 8 * c) = o; }
    LDS_WAIT(); asm volatile("" ::: "memory");
}
struct Args { const float* x; const float* c; const int* pos; const float* w_ada; const float* b_ada; const float* g_norm; const float* w_in; const float* b_forget;
              const float* lq1; const float* lk1; const float* lq2; const float* lk2; const float* g_subln; const float* w_a; const float* w_b; const float* w_out; const float* g_final;
              float* out; unsigned char* ws; int ph_lo, ph_hi, li, pad; };

__global__ void __launch_bounds__(NWAVES * 64, 2) fwd_kernel(Args args) {
    extern __shared__ __attribute__((aligned(16))) unsigned char lds[];
    Frame F;
    F.lds = (LAS unsigned char*)lds;
    F.MISC = (volatile LAS unsigned*)(F.lds + MISC_OFF);
    F.tid = threadIdx.x; F.lane = F.tid & 63; F.wave = __builtin_amdgcn_readfirstlane(F.tid >> 6);
    F.G = gridDim.x; { const int bx = blockIdx.x; F.vcu = (F.G % 8 == 0) ? (bx % 8) * (F.G / 8) + bx / 8 : bx; }
    unsigned char* ws = args.ws;
    F.ctl = (gu32*)(ws + WS_CTL);
    for (int u = F.tid; u < (LDS_BYTES - LDSCTL_OFF) / 4; u += NWAVES * 64) ((LAS unsigned*)(F.lds + LDSCTL_OFF))[u] = 0u;
    __syncthreads();
    XcdBarrier bar; bar.bar = (unsigned*)(F.ctl + CW_BAR); bar.x = 0; bar.st = nullptr;
    if (N_LAUNCHES != PER_PHASE) bar = xcd_barrier_post((unsigned*)(F.ctl + CW_BAR), F.MISC + 8);
#define GRID_BAR(seam) do { if (N_LAUNCHES == PER_PHASE) { if (F.tid == 0) __hip_atomic_store(F.ctl + CW_TMO, 0xBADBA0u | (unsigned)(seam), RLX_AGENT); } else { xcd_barrier(bar); } } while (0)
    const int lo = args.ph_lo, hi = args.ph_hi;
#ifndef PHASE_MASK
#define PHASE_MASK 0xff
#endif
#define IN(k) (((PHASE_MASK >> (k)) & 1) && lo <= (k) && (k) < hi)
#define BOTH(k) (IN(k) && IN((k) + 1))
    bf16* const WQKV_T = (bf16*)(ws + WS_WQKV); bf16* const WG_T = (bf16*)(ws + WS_WG); bf16* const WAB_T = (bf16*)(ws + WS_WAB); bf16* const WO_T = (bf16*)(ws + WS_WO);
    float* const COS_T = (float*)(ws + WS_COS); float* const SIN_T = (float*)(ws + WS_SIN); float* const LOGF = (float*)(ws + WS_LOGF); float* const CUMF = (float*)(ws + WS_CUMF);
    float* const PN = (float*)(ws + WS_PN); float* const MODP = (float*)(ws + WS_MODP); float* const GATE = (float*)(ws + WS_GATE); float* const PS = (float*)(ws + WS_PS);
    bf16* const XN = (bf16*)(ws + WS_XN); bf16* const QAt = (bf16*)(ws + WS_QA); bf16* const KAt = (bf16*)(ws + WS_KA); bf16* const VAt = (bf16*)(ws + WS_VA); bf16* const QBt = (bf16*)(ws + WS_QB);
    bf16* const KBt = (bf16*)args.out; bf16* const VBt = (bf16*)((unsigned char*)args.out + 32 * MiB);
    bf16* const Gt = (bf16*)(ws + WS_G); bf16* const SAt = (bf16*)(ws + WS_SA); bf16* const SBt = (bf16*)args.out; bf16* const MGt = XN;
    const int gw = F.vcu * NWAVES + F.wave, NGW = F.G * NWAVES;

    if (IN(0)) {
        { int t_ = threadIdx.x; asm volatile("" : "+v"(t_)); F.tid = t_; F.lane = t_ & 63; }
        LAS float* scr = (LAS float*)(F.lds + RING_OFF + F.wave * 16384);
        constexpr int I_QKV = 16 * 192, I_G = 16 * 128, I_A = 16 * 32, I_B = 16 * 32, I_O = 16 * 32, I_MOD = 48 * 16, I_ROPE = 1024;
        constexpr int NITEMS = I_QKV + I_G + I_A + I_B + I_O + I_MOD + I_ROPE;
        for (int it = gw; it < NITEMS; it += NGW) {
            int r = it;
            if (r < I_QKV) { p0_tr_item(args.w_in, N_IN, 1024, 0, WQKV_T, 1, scr, r, 192, F.lane); continue; } r -= I_QKV;
            if (r < I_G) { p0_tr_item(args.w_in, N_IN, 1024, 0, WG_T, 2, scr, r, 128, F.lane); continue; } r -= I_G;
            if (r < I_A) { p0_tr_item(args.w_a, 1024, 2048, 0, WAB_T, 0, scr, r, 32, F.lane); continue; } r -= I_A;
            if (r < I_B) { p0_tr_item(args.w_b, 1024, 2048, 1024, WAB_T, 0, scr, r, 32, F.lane); continue; } r -= I_B;
            if (r < I_O) { p0_tr_item(args.w_out, 1024, 1024, 0, WO_T, 0, scr, r, 32, F.lane); continue; } r -= I_O;
            if (r < I_MOD) { const int chunk = r % 48, ks = r / 48, col = chunk * 64 + F.lane; float a0 = 0.f, a1 = 0.f;
#pragma unroll 8
                for (int k = ks * 64; k < ks * 64 + 64; ++k) { const float w = args.w_ada[(size_t)k * 3072 + col]; const float c0 = args.c[k], c1 = args.c[1024 + k];
                    a0 += (c0 / (1.0f + expf(-c0))) * w; a1 += (c1 / (1.0f + expf(-c1))) * w; }
                MODP[(size_t)(ks * 2 + 0) * 3072 + col] = a0; MODP[(size_t)(ks * 2 + 1) * 3072 + col] = a1; continue; } r -= I_MOD;
            {
#pragma unroll 1
                for (int j = 0; j < 8; ++j) { const int idx = r * 512 + j * 64 + F.lane, m = idx >> 5, i = idx & 31;
                    const float ang = __fmul_rn((float)args.pos[m], INV_FREQ[i]); float c, s; sincos_d(ang, c, s); COS_T[idx] = c; SIN_T[idx] = s; } }
        }
        if (BOTH(0)) GRID_BAR(0);
    }
    if (IN(1)) {
        { int t_ = threadIdx.x; asm volatile("" : "+v"(t_)); F.tid = t_; F.lane = t_ & 63; }
        LAS float* gs = (LAS float*)(F.lds); LAS float* sh = gs + 2048; LAS float* wf = sh + 2048;
        for (int e = F.tid; e < 2048; e += NWAVES * 64) { const int b = e >> 10, k = e & 1023; float shv = args.b_ada[k], scv = args.b_ada[1024 + k];
            for (int ks = 0; ks < 16; ++ks) { shv += MODP[(size_t)(ks * 2 + b) * 3072 + k]; scv += MODP[(size_t)(ks * 2 + b) * 3072 + 1024 + k]; }
            gs[e] = args.g_norm[k] * (1.0f + scv); sh[e] = shv;
            if (blockIdx.x == 0) { float gv = args.b_ada[2048 + k]; for (int ks = 0; ks < 16; ++ks) gv += MODP[(size_t)(ks * 2 + b) * 3072 + 2048 + k]; GATE[e] = gv; } }
        for (int e = F.tid; e < 8192; e += NWAVES * 64) { const int k = e >> 3, j = e & 7; wf[j * 1024 + k] = args.w_in[(size_t)k * N_IN + 8192 + j]; }
        __syncthreads();
        for (int m = gw; m < M; m += NGW) { const int b = m >> 13;
            const GAS f32x4* xr = (const GAS f32x4*)(args.x + (size_t)m * DM) + F.lane;
            f32x4 v[4]; float s = 0.f;
#pragma unroll
            for (int j = 0; j < 4; ++j) { v[j] = xr[64 * j]; s += (v[j].x * v[j].x + v[j].y * v[j].y) + (v[j].z * v[j].z + v[j].w * v[j].w); }
            const float rstd = 1.0f / sqrtf(wave_sum(s) * (1.0f / DM) + 1e-6f);
            float fl[8];
#pragma unroll
            for (int jj = 0; jj < 8; ++jj) fl[jj] = 0.f;
            GAS unsigned long long* o8 = (GAS unsigned long long*)(XN + (size_t)m * DM) + F.lane;
#pragma unroll
            for (int j = 0; j < 4; ++j) { const int k = 256 * j + 4 * F.lane;
                const f32x4 g4 = *(const LAS f32x4*)(gs + b * 1024 + k), s4 = *(const LAS f32x4*)(sh + b * 1024 + k);
                f32x4 h; h.x = v[j].x * rstd * g4.x + s4.x; h.y = v[j].y * rstd * g4.y + s4.y; h.z = v[j].z * rstd * g4.z + s4.z; h.w = v[j].w * rstd * g4.w + s4.w;
#pragma unroll
                for (int jj = 0; jj < 8; ++jj) { const f32x4 w4 = *(const LAS f32x4*)(wf + jj * 1024 + k); fl[jj] += (h.x * w4.x + h.y * w4.y) + (h.z * w4.z + h.w * w4.w); }
                o8[64 * j] = (unsigned long long)pk2(h.x, h.y) | ((unsigned long long)pk2(h.z, h.w) << 32); }
            float mine = 0.f;
#pragma unroll
            for (int jj = 0; jj < 8; ++jj) { const float t = wave_sum(fl[jj]); if (F.lane == jj) mine = t; }
            if (F.lane < 8) { const float z = mine + args.b_forget[F.lane]; LOGF[(size_t)m * 8 + F.lane] = fminf(z, 0.f) - log1pf(expf(-fabsf(z))); }
        }
        if (BOTH(1)) GRID_BAR(1);
    }
    if (IN(2)) {
        { int t_ = threadIdx.x; asm volatile("" : "+v"(t_)); F.tid = t_; F.lane = t_ & 63; }
        if (blockIdx.x < 16) { const int bh = blockIdx.x, b = bh >> 3, h = bh & 7; LAS double* wt = (LAS double*)(F.lds);
            double pre[16]; double run = 0.0;
#pragma unroll
            for (int i = 0; i < 16; ++i) { run += (double)LOGF[((size_t)b * SEQ + F.tid * 16 + i) * 8 + h]; pre[i] = run; }
            double inc = run;
#pragma unroll
            for (int o = 1; o < 64; o <<= 1) { const double t = __shfl_up(inc, o); if (F.lane >= o) inc += t; }
            if (F.lane == 63) wt[F.wave] = inc;
            __syncthreads();
            double base = inc - run;
            for (int w = 0; w < F.wave; ++w) base += wt[w];
#pragma unroll
            for (int i = 0; i < 16; ++i) CUMF[(size_t)bh * SEQ + F.tid * 16 + i] = (float)(base + pre[i]);
            __syncthreads(); }
        pg8::Gemm g{XN, WQKV_T, M, 6144, DM}; pg8::StaticOrder S; S.init(M, 6144, F.G, (int)blockIdx.x);
        pg8::EpiQKV E{QAt, KAt, VAt, QBt, KBt, VBt, COS_T, SIN_T, PN};
        pg8::gemm_phase<pg8::EpiQKV, pg8::StaticOrder, true, true>(F.lds + RING_OFF, g, S, E);
        if (BOTH(2)) GRID_BAR(2);
    }
    if (IN(3)) {
        { int t_ = threadIdx.x; asm volatile("" : "+v"(t_)); F.tid = t_; F.lane = t_ & 63; }
        float s1 = 0.f, s2 = 0.f;
        for (int i = 0; i < 64; ++i) { s1 += args.lq1[i] * args.lk1[i]; s2 += args.lq2[i] * args.lk2[i]; }
        const float lam = expf(s1) - expf(s2) + 0.2f;
        const int g = blockIdx.x & 7; gu32* qctr = F.ctl + CW_Q + 64 * g; volatile LAS unsigned* qw = F.MISC + 16;
        char* albs = (char*)lds + RING_OFF;
#define PULL(dst) do { if (F.tid == 0) qw[0] = xb_add((unsigned*)qctr, 1u); __syncthreads(); dst = (int)qw[0]; __syncthreads(); } while (0)
#define REF_B(r, ix) do { const int bh_ = 2 * g + (ix) / 32, qb_ = 31 - ((ix) % 32); r.P0 = qb_ * 256; r.Q = QBt + ((size_t)bh_ * SEQ + r.P0) * HD; r.O = QBt + ((size_t)bh_ * SEQ + r.P0) * HD; \
        r.K = KBt + (size_t)bh_ * SEQ * HD; r.V = VBt + (size_t)bh_ * SEQ * HD; r.F = CUMF + (size_t)bh_ * SEQ; } while (0)
#define REF_A(r, ix) do { const int bh_ = 2 * g + (ix) / 64, qb_ = 63 - ((ix) % 64); r.P0 = qb_ * 128; r.Q = QAt + ((size_t)bh_ * SEQ + r.P0) * HD; r.O = QAt + ((size_t)bh_ * SEQ + r.P0) * HD; \
        r.K = KAt + (size_t)bh_ * SEQ * HD; r.V = VAt + (size_t)bh_ * SEQ * HD; r.F = CUMF; } while (0)
        float bnd[2];
        { volatile LAS float* red = (volatile LAS float*)(F.lds + RING_OFF);
          for (int hl = 0; hl < 2; ++hl) { float mx[2];
              for (int t2 = 0; t2 < 2; ++t2) { float m_ = 0.f; const GAS f32x4* pn = (const GAS f32x4*)(PN + ((size_t)t2 * 16 * SEQ + (size_t)(2 * g + hl) * SEQ) * 4);
                  for (int r = F.tid; r < SEQ; r += NWAVES * 64) { const f32x4 v = pn[r]; m_ = fmaxf(m_, (v.x + v.y) + (v.z + v.w)); }
#pragma unroll
                  for (int o = 1; o < 64; o <<= 1) m_ = fmaxf(m_, __shfl_xor(m_, o));
                  if (F.lane == 0) red[(hl * 2 + t2) * 8 + F.wave] = m_; }
          }
          __syncthreads();
          for (int hl = 0; hl < 2; ++hl) { float q2 = 0.f, k2 = 0.f;
              for (int w = 0; w < 8; ++w) { q2 = fmaxf(q2, red[(hl * 2 + 0) * 8 + w]); k2 = fmaxf(k2, red[(hl * 2 + 1) * 8 + w]); }
              bnd[hl] = __uint_as_float((unsigned)__builtin_amdgcn_readfirstlane((int)__float_as_uint((2.04f * sqrtf(q2 * k2) + 175.0f) * 0.6931471805599453f))); }
          __syncthreads(); }
        int idx; PULL(idx);
#ifndef ATT_MASK
#define ATT_MASK 3
#endif
        if ((ATT_MASK & 2) && !(args.pad & 2) && idx < 64) { att::BlockRef cur, nxt; REF_B(cur, idx); att::Seam S; att::attn_prime<1>(cur, albs, S);
            int ntc = att::fox_nt(cur.F, cur.P0, (idx / 32) ? bnd[1] : bnd[0]);
            for (;;) { int nidx; PULL(nidx); const bool more = nidx < 64; nxt = cur; int ntn = ntc; if (more) { REF_B(nxt, nidx); ntn = att::fox_nt(nxt.F, nxt.P0, (nidx / 32) ? bnd[1] : bnd[0]); }
                att::attn_block<1>(cur, nxt, ntc, lam, args.g_subln, albs, S, (args.pad & 1) != 0); idx = nidx; if (!more) break; cur = nxt; ntc = ntn; } }
        if ((ATT_MASK & 1) && !(args.pad & 4) && idx < 192) { att::BlockRef cur, nxt; REF_A(cur, idx - 64); att::Seam S; att::attn_prime<0>(cur, albs, S);
            for (;;) { int nidx; PULL(nidx); const bool more = nidx < 192; nxt = cur; if (more) REF_A(nxt, nidx - 64);
                att::attn_block<0>(cur, nxt, cur.P0 / 64 + 2, lam, args.g_subln, albs, S, (args.pad & 1) != 0); idx = nidx; if (!more) break; cur = nxt; } }
#undef PULL
#undef REF_A
#undef REF_B
        if (BOTH(3)) GRID_BAR(3);
    }
    if (IN(4)) {
        pg8::Gemm g{XN, WG_T, M, 4096, DM}; pg8::StaticOrder S; S.init(M, 4096, F.G, (int)blockIdx.x);
        pg8::EpiGate E{QAt, QBt, Gt, SAt, SBt};
        pg8::gemm_phase<pg8::EpiGate, pg8::StaticOrder, true, true>(F.lds + RING_OFF, g, S, E);
        if (BOTH(4)) GRID_BAR(4);
    }
    if (IN(5)) {
        pg8::Gemm g{Gt, WAB_T, M, 1024, 2048}; pg8::StaticOrder S; S.init(M, 1024, F.G, (int)blockIdx.x);
        pg8::EpiMerge E{SAt, SBt, MGt};
        pg8::gemm_phase<pg8::EpiMerge, pg8::StaticOrder, true, true>(F.lds + RING_OFF, g, S, E);
        if (BOTH(5)) GRID_BAR(5);
    }
    if (IN(6)) {
        pg8::Gemm g{MGt, WO_T, M, 1024, DM}; pg8::StaticOrder S; S.init(M, 1024, F.G, (int)blockIdx.x);
        pg8::EpiOut E{args.x, args.out, GATE, PS};
        pg8::gemm_phase<pg8::EpiOut, pg8::StaticOrder, true, true>(F.lds + RING_OFF, g, S, E);
        if (BOTH(6)) GRID_BAR(6);
    }
    if (IN(7)) {
        int ln7 = threadIdx.x; asm volatile("" : "+v"(ln7)); ln7 &= 63;
        for (int m = gw; m < M; m += NGW) {
            float p = ln7 < 16 ? PS[(size_t)m * 16 + ln7] : 0.f; p = wave_sum(p);
            const float rstd = 1.0f / sqrtf(p * (1.0f / DM) + 1e-6f);
            GAS f32x4* orow = (GAS f32x4*)(args.out + (size_t)m * DM) + ln7; const GAS f32x4* gf = (const GAS f32x4*)args.g_final + ln7;
#pragma unroll
            for (int j = 0; j < 4; ++j) { f32x4 v = orow[64 * j]; const f32x4 g4 = gf[64 * j]; v.x *= rstd * g4.x; v.y *= rstd * g4.y; v.z *= rstd * g4.z; v.w *= rstd * g4.w; orow[64 * j] = v; }
        }
    }
#undef IN
#undef BOTH
#undef GRID_BAR
}

extern "C" void kernel_launch(void* const* d_in, const int* in_sizes, int n_in, void* d_out, int out_size, void* d_ws, size_t ws_size, hipStream_t stream) {
    static int grid = 0;
    if (grid == 0) {
        if (n_in != 17 || in_sizes[0] != M * DM || out_size != M * DM || ws_size < WS_END) { fprintf(stderr, "kernel_launch: unexpected shapes (n_in %d, in0 %d, out %d, ws %zu); nothing launched\n", n_in, n_in > 0 ? in_sizes[0] : -1, out_size, ws_size); grid = -1; return; }
        int dev = 0, cus = 0;
        if (hipGetDevice(&dev) != hipSuccess || hipDeviceGetAttribute(&cus, hipDeviceAttributeMultiprocessorCount, dev) != hipSuccess) { fprintf(stderr, "kernel_launch: device query failed\n"); grid = -1; return; }
        if (hipFuncSetAttribute((const void*)fwd_kernel, hipFuncAttributeMaxDynamicSharedMemorySize, LDS_BYTES) != hipSuccess) { fprintf(stderr, "kernel_launch: hipFuncSetAttribute failed\n"); grid = -1; return; }
        int per_cu = 0;
        if (hipOccupancyMaxActiveBlocksPerMultiprocessor(&per_cu, (const void*)fwd_kernel, NWAVES * 64, LDS_BYTES) != hipSuccess || per_cu < 1)
            fprintf(stderr, "kernel_launch: note: occupancy query reports %d workgroups per CU\n", per_cu);
        (void)hipGetLastError();
        grid = cus;
    }
    if (grid < 0) return;
    if (hipMemsetAsync((char*)d_ws + WS_CTL, 0, CTL_ZERO_BYTES, stream) != hipSuccess) { fprintf(stderr, "kernel_launch: hipMemsetAsync failed\n"); return; }
    Args a{};
    a.x = (const float*)d_in[0]; a.c = (const float*)d_in[1]; a.pos = (const int*)d_in[2]; a.w_ada = (const float*)d_in[3]; a.b_ada = (const float*)d_in[4]; a.g_norm = (const float*)d_in[5];
    a.w_in = (const float*)d_in[6]; a.b_forget = (const float*)d_in[7]; a.lq1 = (const float*)d_in[8]; a.lk1 = (const float*)d_in[9]; a.lq2 = (const float*)d_in[10]; a.lk2 = (const float*)d_in[11];
    a.g_subln = (const float*)d_in[12]; a.w_a = (const float*)d_in[13]; a.w_b = (const float*)d_in[14]; a.w_out = (const float*)d_in[15]; a.g_final = (const float*)d_in[16];
    a.out = (float*)d_out; a.ws = (unsigned char*)d_ws;
    for (int li = 0; li < N_LAUNCHES; ++li) {
        a.ph_lo = (N_LAUNCHES == PER_PHASE) ? li : 0; a.ph_hi = (N_LAUNCHES == PER_PHASE) ? li + 1 : PER_PHASE; a.li = li;
#ifndef DUP_MASK
#define DUP_MASK 0
#endif
#ifndef DRY_MODE
#define DRY_MODE 0
#endif
        if (DRY_MODE && N_LAUNCHES == PER_PHASE && li == 3) { a.pad = DRY_MODE == 1 ? 1 : DRY_MODE == 2 ? (1 | 2) : (1 | 4);
            hipLaunchKernelGGL(fwd_kernel, dim3(grid), dim3(NWAVES * 64), LDS_BYTES, stream, a); a.pad = 0;
            (void)hipMemsetAsync((char*)d_ws + WS_CTL + CW_Q * 4, 0, 8 * 64 * 4, stream); }
        for (int rep_ = 0; rep_ <= ((N_LAUNCHES == PER_PHASE) ? ((DUP_MASK >> li) & 1) : 0); ++rep_)
        hipLaunchKernelGGL(fwd_kernel, dim3(grid), dim3(NWAVES * 64), LDS_BYTES, stream, a);
        const hipError_t le = hipPeekAtLastError();
        if (le != hipSuccess) { fprintf(stderr, "kernel_launch: launch %d failed: %s\n", li, hipGetErrorName(le)); break; }
    }
}
```
